# Optimizing an MI355X kernel written in HIP

```python
import jax, jax.numpy as jnp
from jax import lax
import numpy as np

D_MODEL = 1024
BATCH = 8
SEQ = 2048
DEPTH = 2
DEC_BATCH = 128
DEC_SEQ = 8
PAST_LEN = 16384
PAGE_SIZE = 128

N_META = 16
RW_HEADS = 8
RW_HD = 64
D_RW = RW_HEADS * RW_HD
RW_W_LORA = 64
RW_A_LORA = 64
RW_G_LORA = 128
RW_SHIFT_W = 3 * D_RW + RW_W_LORA + RW_A_LORA + RW_G_LORA
RW_GN_EPS = 64e-5
ML_HEADS = 4
ML_HD = 128
D_ML = ML_HEADS * ML_HD
CONV_W = 4
ML_CHUNK = 64
ML_IN_W = 4 * D_ML + 2 * ML_HEADS
ML_GN_EPS = 1e-5
N_IN = RW_SHIFT_W + ML_IN_W + 2 * D_MODEL
D_FF = 4 * D_MODEL
RMS_EPS = 1e-6

kernel_name = "rwkv7_mlstm_gated_hybrid_step"

F32 = jnp.float32


def _split(a, sizes):
    idx = [int(i) for i in np.cumsum(sizes)[:-1]]
    return jnp.split(a, idx, axis=-1)


def _rms_norm(x, g):
    xf = x.astype(F32)
    y = xf * lax.rsqrt(jnp.mean(xf * xf, axis=-1, keepdims=True) + RMS_EPS)
    return (y * g.astype(F32)).astype(x.dtype)


def _head_norm(x, g, eps):
    mu = jnp.mean(x, axis=-1, keepdims=True)
    xc = x - mu
    var = jnp.mean(xc * xc, axis=-1, keepdims=True)
    return xc * lax.rsqrt(var + eps) * g.astype(F32)


def _rwkv7_step(S, inp):
    r, w, k, v, kk, a = inp
    sa = jnp.einsum('bhvk,bhk->bhv', S, -kk)
    S = S * w[:, :, None, :] + sa[..., None] * (kk * a)[:, :, None, :] + v[..., None] * k[:, :, None, :]
    return S, jnp.einsum('bhvk,bhk->bhv', S, r)


def _rwkv7_branch(z, shift_buf, S0, mu, w0, w_up, a0, a_up, g_up, k_k, k_a, r_k, gn_g, gn_b):
    B, T, _ = z.shape
    z = z.astype(F32)
    prev = jnp.concatenate([shift_buf[:, None].astype(F32), z[:, :-1]], axis=1)
    zs = z + (prev - z) * mu.astype(F32)
    r, k, v, wl, al, gl = _split(zs, [D_RW, D_RW, D_RW, RW_W_LORA, RW_A_LORA, RW_G_LORA])
    w = -jax.nn.softplus(-(w0.astype(F32) + jnp.tanh(wl) @ w_up.astype(F32))) - 0.5
    decay = jnp.exp(-jnp.exp(w))
    a = jax.nn.sigmoid(a0.astype(F32) + al @ a_up.astype(F32))
    g = jax.nn.sigmoid(gl) @ g_up.astype(F32)
    heads = lambda t: t.reshape(B, T, RW_HEADS, RW_HD)
    kk = heads(k * k_k.astype(F32))
    kk = kk * lax.rsqrt(jnp.maximum(jnp.sum(kk * kk, axis=-1, keepdims=True), 1e-24))
    k = k * (1.0 + (a - 1.0) * k_a.astype(F32))
    r, decay, k, v, a = heads(r), heads(decay), heads(k), heads(v), heads(a)
    tm = lambda t: jnp.swapaxes(t, 0, 1)
    S_T, y = lax.scan(_rwkv7_step, S0.astype(F32), (tm(r), tm(decay), tm(k), tm(v), tm(kk), tm(a)))
    y = tm(y)
    y = _head_norm(y, gn_g, RW_GN_EPS) + gn_b.astype(F32)
    y = y + jnp.sum(r * k * r_k.astype(F32), axis=-1, keepdims=True) * v
    y = y.reshape(B, T, D_RW) * g
    return y, z[:, -1], S_T


def _mlstm_chunk(carry, inp):
    C, n, m = carry
    q, k, v, ig, lf = inp
    L = q.shape[1]
    bt = jnp.swapaxes(jnp.cumsum(lf, axis=1), 1, 2)
    igt = jnp.swapaxes(ig, 1, 2)
    causal = jnp.tril(jnp.ones((L, L), dtype=bool))
    dlog = jnp.where(causal, bt[..., :, None] - bt[..., None, :] + igt[..., None, :], -jnp.inf)
    inter = bt + m[..., None]
    m_t = jnp.maximum(inter, jnp.max(dlog, axis=-1))
    A = jnp.exp(dlog - m_t[..., None])
    sc = jnp.exp(inter - m_t)
    aqk = A * jnp.einsum('blhd,bshd->bhls', q, k)
    num = jnp.einsum('bhls,bshd->blhd', aqk, v) + jnp.swapaxes(sc, 1, 2)[..., None] * jnp.einsum('bhvk,blhk->blhv', C, q)
    den = jnp.sum(aqk, axis=-1) + sc * jnp.einsum('bhk,blhk->bhl', n, q)
    denom = jnp.maximum(jnp.abs(den), jnp.exp(-m_t))
    h = num / jnp.swapaxes(denom, 1, 2)[..., None]
    m_new = m_t[..., -1]
    wc = jnp.exp(bt[..., -1:] - bt + igt - m_new[..., None])
    dec = jnp.exp(bt[..., -1] + m - m_new)
    C_new = dec[..., None, None] * C + jnp.einsum('bhs,bshv,bshk->bhvk', wc, v, k)
    n_new = dec[..., None] * n + jnp.einsum('bhs,bshk->bhk', wc, k)
    return (C_new, n_new, m_new), h


def _mlstm_run(state, seqs, chunk):
    B, T = seqs[0].shape[:2]
    nc = T // chunk
    blk = lambda a: jnp.swapaxes(a.reshape((B, nc, chunk) + a.shape[2:]), 0, 1)
    state, h = lax.scan(_mlstm_chunk, state, tuple(blk(a) for a in seqs))
    h = jnp.swapaxes(h, 0, 1).reshape((B, T) + h.shape[3:])
    return state, h


def _mlstm_branch(z, conv_buf, C0, n0, m0, conv_w, conv_b, i_bias, f_bias, gn_g, n_lead, chunk):
    B, T, _ = z.shape
    z = z.astype(F32)
    qk_raw, v, o, ig, fg = _split(z, [2 * D_ML, D_ML, D_ML, ML_HEADS, ML_HEADS])
    xp = jnp.concatenate([conv_buf.astype(F32), qk_raw], axis=1)
    cw = conv_w.astype(F32)
    qk = conv_b.astype(F32) + xp[:, 0:T] * cw[0]
    for j in range(1, CONV_W):
        qk = qk + xp[:, j:j + T] * cw[j]
    qk = jax.nn.silu(qk)
    q, k = jnp.split(qk, 2, axis=-1)
    heads = lambda t: t.reshape(B, T, ML_HEADS, ML_HD)
    q, k, v = heads(q), heads(k) * (ML_HD ** -0.5), heads(v)
    ig = ig + i_bias.astype(F32)
    lf = jax.nn.log_sigmoid(fg + f_bias.astype(F32))
    state = (C0.astype(F32), n0.astype(F32), m0.astype(F32))
    seqs = (q, k, v, ig, lf)
    if n_lead:
        state, h_lead = _mlstm_run(state, tuple(s[:, :n_lead] for s in seqs), n_lead)
        state, h_rest = _mlstm_run(state, tuple(s[:, n_lead:] for s in seqs), chunk)
        h = jnp.concatenate([h_lead, h_rest], axis=1)
    else:
        state, h = _mlstm_run(state, seqs, chunk)
    h = _head_norm(h, gn_g, ML_GN_EPS).reshape(B, T, D_ML) * jax.nn.sigmoid(o)
    return h, xp[:, -(CONV_W - 1):], state


def _layer(x, st, lp, n_lead, chunk):
    S0, sh0, C0, n0, m0, cb0 = st
    u = _rms_norm(x, lp['pre1'])
    z = u @ lp['w_in']
    z_rw, z_ml, z_gate = _split(z, [RW_SHIFT_W, ML_IN_W, 2 * D_MODEL])
    ya, sh1, S1 = _rwkv7_branch(z_rw, sh0, S0, lp['rw_mu'], lp['rw_w0'], lp['rw_w_up'], lp['rw_a0'],
                                lp['rw_a_up'], lp['rw_g_up'], lp['rw_k_k'], lp['rw_k_a'], lp['rw_r_k'],
                                lp['rw_gn_g'], lp['rw_gn_b'])
    yb, cb1, (C1, n1, m1) = _mlstm_branch(z_ml, cb0, C0, n0, m0, lp['ml_conv_w'], lp['ml_conv_b'],
                                          lp['ml_i_bias'], lp['ml_f_bias'], lp['ml_gn_g'], n_lead, chunk)
    ga, gb = jnp.split(jax.nn.sigmoid(z_gate.astype(F32)), 2, axis=-1)
    merged = ga * (ya @ lp['p_a'].astype(F32)) + gb * (yb @ lp['p_b'].astype(F32))
    h = x + _rms_norm(merged.astype(x.dtype) @ lp['w_out'], lp['post1'])
    u2 = _rms_norm(h, lp['pre2'])
    f = jnp.square(jax.nn.relu(u2 @ lp['w_ff_up'])) @ lp['w_ff_down']
    out = h + _rms_norm(f, lp['post2'])
    dt = x.dtype
    return out, (S1.astype(dt), sh1.astype(dt), C1.astype(dt), n1.astype(dt), m1.astype(dt), cb1.astype(dt))


def setup_inputs(seed: int = 0) -> dict:
    key = jax.random.key(seed)
    ks = jax.random.split(key, 40)
    nrm = lambda i, shape, s: jax.random.normal(ks[i], shape, F32) * s
    L = DEPTH
    d = {}
    d['x_prompt'] = nrm(0, (BATCH, SEQ, D_MODEL), 1.0)
    d['x_sample'] = nrm(1, (DEC_BATCH, DEC_SEQ, D_MODEL), 1.0)
    d['state_rwkv_S'] = nrm(2, (L, DEC_BATCH, RW_HEADS, RW_HD, RW_HD), 0.1)
    d['state_rwkv_shift'] = nrm(3, (L, DEC_BATCH, RW_SHIFT_W), 1.0)
    d['state_mlstm_C'] = nrm(4, (L, DEC_BATCH, ML_HEADS, ML_HD, ML_HD), 0.3)
    d['state_mlstm_n'] = nrm(5, (L, DEC_BATCH, ML_HEADS, ML_HD), 0.3)
    d['state_mlstm_m'] = nrm(6, (L, DEC_BATCH, ML_HEADS), 0.5)
    d['state_mlstm_conv'] = nrm(7, (L, DEC_BATCH, CONV_W - 1, 2 * D_ML), 1.0)
    d['meta_tokens'] = nrm(8, (N_META, D_MODEL), 1.0)
    d['w_in'] = nrm(9, (L, D_MODEL, N_IN), D_MODEL ** -0.5)
    d['rw_mu'] = jax.random.uniform(ks[10], (L, RW_SHIFT_W), F32)
    d['rw_w0'] = jax.random.uniform(ks[11], (L, D_RW), F32, -6.0, 1.0)
    d['rw_w_up'] = nrm(12, (L, RW_W_LORA, D_RW), 0.5 * RW_W_LORA ** -0.5)
    d['rw_a0'] = nrm(13, (L, D_RW), 0.5)
    d['rw_a_up'] = nrm(14, (L, RW_A_LORA, D_RW), 0.5 * RW_A_LORA ** -0.5)
    d['rw_g_up'] = nrm(15, (L, RW_G_LORA, D_RW), RW_G_LORA ** -0.5)
    d['rw_k_k'] = 0.85 + nrm(16, (L, D_RW), 0.02)
    d['rw_k_a'] = 1.0 + nrm(17, (L, D_RW), 0.02)
    d['rw_r_k'] = nrm(18, (L, RW_HEADS, RW_HD), 0.1)
    d['rw_gn_g'] = 1.0 + nrm(19, (L, RW_HEADS, RW_HD), 0.02)
    d['rw_gn_b'] = nrm(20, (L, RW_HEADS, RW_HD), 0.02)
    d['ml_conv_w'] = nrm(21, (L, CONV_W, 2 * D_ML), CONV_W ** -0.5)
    d['ml_conv_b'] = nrm(22, (L, 2 * D_ML), 0.01)
    d['ml_i_bias'] = nrm(23, (L, ML_HEADS), 0.1)
    d['ml_f_bias'] = jnp.linspace(3.0, 6.0, ML_HEADS, dtype=F32)[None] + nrm(24, (L, ML_HEADS), 0.1)
    d['ml_gn_g'] = 1.0 + nrm(25, (L, ML_HEADS, ML_HD), 0.02)
    d['p_a'] = nrm(26, (L, D_RW, D_MODEL), D_RW ** -0.5)
    d['p_b'] = nrm(27, (L, D_ML, D_MODEL), D_ML ** -0.5)
    d['w_out'] = nrm(28, (L, D_MODEL, D_MODEL), D_MODEL ** -0.5)
    d['pre1'] = 1.0 + nrm(29, (L, D_MODEL), 0.02)
    d['post1'] = 1.0 + nrm(30, (L, D_MODEL), 0.02)
    d['pre2'] = 1.0 + nrm(31, (L, D_MODEL), 0.02)
    d['post2'] = 1.0 + nrm(32, (L, D_MODEL), 0.02)
    d['w_ff_up'] = nrm(33, (L, D_MODEL, D_FF), D_MODEL ** -0.5)
    d['w_ff_down'] = nrm(34, (L, D_FF, D_MODEL), D_FF ** -0.5)
    return d


def reference(x_prompt, x_sample, state_rwkv_S, state_rwkv_shift, state_mlstm_C, state_mlstm_n,
              state_mlstm_m, state_mlstm_conv, meta_tokens, w_in, rw_mu, rw_w0, rw_w_up, rw_a0, rw_a_up,
              rw_g_up, rw_k_k, rw_k_a, rw_r_k, rw_gn_g, rw_gn_b, ml_conv_w, ml_conv_b, ml_i_bias, ml_f_bias,
              ml_gn_g, p_a, p_b, w_out, pre1, post1, pre2, post2, w_ff_up, w_ff_down):
    B = x_prompt.shape[0]
    dt = x_prompt.dtype
    xp = jnp.concatenate([jnp.broadcast_to(meta_tokens[None].astype(dt), (B, N_META, D_MODEL)), x_prompt], axis=1)
    xs = x_sample
    zero_state = (jnp.zeros((B, RW_HEADS, RW_HD, RW_HD), F32), jnp.zeros((B, RW_SHIFT_W), F32),
                  jnp.zeros((B, ML_HEADS, ML_HD, ML_HD), F32), jnp.zeros((B, ML_HEADS, ML_HD), F32),
                  jnp.zeros((B, ML_HEADS), F32), jnp.zeros((B, CONV_W - 1, 2 * D_ML), F32))
    p_states, s_states = [], []
    for l in range(DEPTH):
        lp = dict(w_in=w_in[l], rw_mu=rw_mu[l], rw_w0=rw_w0[l], rw_w_up=rw_w_up[l], rw_a0=rw_a0[l],
                  rw_a_up=rw_a_up[l], rw_g_up=rw_g_up[l], rw_k_k=rw_k_k[l], rw_k_a=rw_k_a[l], rw_r_k=rw_r_k[l],
                  rw_gn_g=rw_gn_g[l], rw_gn_b=rw_gn_b[l], ml_conv_w=ml_conv_w[l], ml_conv_b=ml_conv_b[l],
                  ml_i_bias=ml_i_bias[l], ml_f_bias=ml_f_bias[l], ml_gn_g=ml_gn_g[l], p_a=p_a[l], p_b=p_b[l],
                  w_out=w_out[l], pre1=pre1[l], post1=post1[l], pre2=pre2[l], post2=post2[l],
                  w_ff_up=w_ff_up[l], w_ff_down=w_ff_down[l])
        xp, st_p = _layer(xp, zero_state, lp, N_META, ML_CHUNK)
        st_in = (state_rwkv_S[l], state_rwkv_shift[l], state_mlstm_C[l], state_mlstm_n[l],
                 state_mlstm_m[l], state_mlstm_conv[l])
        xs, st_s = _layer(xs, st_in, lp, 0, xs.shape[1])
        p_states.append(st_p)
        s_states.append(st_s)
    stk = lambda lst, i: jnp.stack([s[i] for s in lst])
    y_prompt = xp[:, N_META:]
    return (y_prompt, xs,
            stk(p_states, 0), stk(p_states, 1), stk(p_states, 2), stk(p_states, 3), stk(p_states, 4), stk(p_states, 5),
            stk(s_states, 0), stk(s_states, 1), stk(s_states, 2), stk(s_states, 3), stk(s_states, 4), stk(s_states, 5))
```

```cpp
#include <hip/hip_runtime.h>
#include <hip/hip_cooperative_groups.h>
#include <cstdio>
#include <cstdint>
namespace cg = cooperative_groups;

typedef unsigned short bf16;
typedef __attribute__((ext_vector_type(8))) __bf16 b8;
typedef __attribute__((ext_vector_type(16))) float f32x16;
typedef __attribute__((ext_vector_type(4))) float f32x4;

constexpr int MT = 17536;
constexpr int ROW_META = 16384;
constexpr int ROW_S = 16512;
constexpr int ZW = 3840;
constexpr int NIN = 5896;
constexpr int NTHR = 512;

constexpr size_t O_YS = 16777216;
constexpr size_t O_PS = O_YS + 1048576;
constexpr size_t O_PSH = O_PS + 524288;
constexpr size_t O_PC = O_PSH + 28672;
constexpr size_t O_PN = O_PC + 1048576;
constexpr size_t O_PM = O_PN + 8192;
constexpr size_t O_PCV = O_PM + 64;
constexpr size_t O_SS = O_PCV + 49152;
constexpr size_t O_SSH = O_SS + 8388608;
constexpr size_t O_SC = O_SSH + 458752;
constexpr size_t O_SN = O_SC + 16777216;
constexpr size_t O_SM = O_SN + 131072;
constexpr size_t O_SCV = O_SM + 1024;
constexpr size_t O_END = O_SCV + 786432;

constexpr int MP = 17664;
constexpr size_t W_IN = 0, W_PA = 6029312, W_PB = 6553600, W_OUT2 = 7077888, W_UP = 9175040, W_DN = 13369344;
constexpr size_t WBL = 17563648;
constexpr size_t OFF_META = 2 * WBL * 2;
constexpr size_t OFF_U = OFF_META + 524288;
constexpr size_t OFF_BIG = OFF_U + (size_t)MP * 1024 * 2;
constexpr size_t OFF_T = OFF_BIG + (size_t)MP * 2048 * 2;
constexpr size_t OFF_YA = OFF_BIG + (size_t)MP * 2048 * 2 + (size_t)MP * 1024 * 4;
constexpr size_t OFF_YB = OFF_YA + (size_t)MP * 512 * 2;
constexpr size_t OFF_G = OFF_YB + (size_t)MP * 512 * 2;
constexpr size_t OFF_FLAG = OFF_G + (size_t)MT * 8 * 4;
constexpr size_t OFF_RING = OFF_FLAG + 2 * 64 * 256;
constexpr int RING_SLOT_F = 7 * 2048 + 32;
constexpr int RING_NSLOT = 4;
constexpr size_t OFF_BAR = OFF_RING + (size_t)64 * RING_NSLOT * RING_SLOT_F * 4;
constexpr size_t OFF_CNT = OFF_BAR + 16384;
constexpr size_t WS_END = OFF_CNT + 110592;

constexpr int LDS_BYTES = 157184;

struct P {
  const float* in[35];
  float* out;
  unsigned char* ws;
};

__device__ __forceinline__ bf16 f2bf(float f) {
  unsigned u = __float_as_uint(f);
  u += 0x7FFFu + ((u >> 16) & 1u);
  return (bf16)(u >> 16);
}
__device__ __forceinline__ float bf2f(bf16 h) { return __uint_as_float(((unsigned)h) << 16); }
__device__ __forceinline__ unsigned pack2(float a, float b) { return (unsigned)f2bf(a) | ((unsigned)f2bf(b) << 16); }
__device__ __forceinline__ float lo2f(unsigned u) { return __uint_as_float(u << 16); }
__device__ __forceinline__ float hi2f(unsigned u) { return __uint_as_float(u & 0xFFFF0000u); }
__device__ __forceinline__ void unpack8(const uint4& v, float* f) {
  f[0] = lo2f(v.x); f[1] = hi2f(v.x); f[2] = lo2f(v.y); f[3] = hi2f(v.y);
  f[4] = lo2f(v.z); f[5] = hi2f(v.z); f[6] = lo2f(v.w); f[7] = hi2f(v.w);
}
__device__ __forceinline__ uint4 pack8(const float* f) {
  uint4 v; v.x = pack2(f[0], f[1]); v.y = pack2(f[2], f[3]); v.z = pack2(f[4], f[5]); v.w = pack2(f[6], f[7]); return v;
}
__device__ __forceinline__ float sigmoidf(float x) { return __builtin_amdgcn_rcpf(1.f + __expf(-x)); }
__device__ __forceinline__ float softplusf(float x) { return fmaxf(x, 0.f) + log1pf(__expf(-fabsf(x))); }
__device__ __forceinline__ float wave_sum(float v) {
#pragma unroll
  for (int o = 32; o; o >>= 1) v += __shfl_xor(v, o);
  return v;
}
template <int CTRL> __device__ __forceinline__ float dppf(float v) {
  return __int_as_float(__builtin_amdgcn_update_dpp(0, __float_as_int(v), CTRL, 0xF, 0xF, true));
}
__device__ __forceinline__ float sum16(float v) {
  v += dppf<0xB1>(v);
  v += dppf<0x4E>(v);
  v += dppf<0x141>(v);
  v += dppf<0x140>(v);
  return v;
}
__device__ __forceinline__ float* xh_row(const P& p, int r) {
  if (r < ROW_META) return p.out + (size_t)r * 1024;
  if (r < ROW_S) return (float*)(p.ws + OFF_META) + (size_t)(r - ROW_META) * 1024;
  return p.out + O_YS + (size_t)(r - ROW_S) * 1024;
}
__device__ __forceinline__ int seq_row(int type, int b, int t) {
  if (type) return ROW_S + b * 8 + t;
  return t < 16 ? ROW_META + b * 16 + t : b * 2048 + t - 16;
}
__device__ __forceinline__ int tidx() { int t = threadIdx.x; asm volatile("" : "+v"(t)); return t; }
__device__ __forceinline__ b8 ldsfrag(const unsigned char* p) { return *(const b8*)p; }

__device__ __forceinline__ void conv_tile(const float* __restrict__ src, int ld, int k0, int sc0, bf16* __restrict__ dst, int K, int dn0, int dk0, int dk1, float* tile) {
  const int tid = tidx();
  float4 v[8];
#pragma unroll
  for (int i = 0; i < 8; ++i) {
    int idx = tid + NTHR * i; int k = idx >> 6, n4 = (idx & 63) * 4;
    v[i] = *(const float4*)(src + (size_t)(k0 + k) * ld + sc0 + n4);
  }
#pragma unroll
  for (int i = 0; i < 8; ++i) {
    int idx = tid + NTHR * i; int k = idx >> 6, n4 = (idx & 63) * 4;
    float* t = tile + k * 257 + n4;
    t[0] = v[i].x; t[1] = v[i].y; t[2] = v[i].z; t[3] = v[i].w;
  }
  __syncthreads();
#pragma unroll
  for (int i = 0; i < 4; ++i) {
    int idx = tid + NTHR * i; int kc = idx >> 8, n = idx & 255;
    float f[8];
#pragma unroll
    for (int e = 0; e < 8; ++e) f[e] = tile[(kc * 8 + e) * 257 + n];
    uint4 pk = pack8(f);
    *(uint4*)(dst + (size_t)(dn0 + n) * K + dk0 + kc * 8) = pk;
    if (dk1 >= 0) *(uint4*)(dst + (size_t)(dn0 + n) * K + dk1 + kc * 8) = pk;
  }
  __syncthreads();
}

__device__ __forceinline__ void phase_convert(const P& p, unsigned char* lds) {
  float* tile = (float*)lds;
  for (int t = blockIdx.x; t < 2016; t += gridDim.x) {
    int l = t / 1008, r = t % 1008;
    bf16* wb = (bf16*)p.ws + (size_t)l * WBL;
    if (r < 368) {
      int kt = r / 23, nt = r % 23;
      conv_tile(p.in[9] + (size_t)l * 1024 * NIN, NIN, kt * 64, nt * 256 + (nt >= 15 ? 8 : 0), wb + W_IN, 1024, nt * 256, kt * 64, -1, tile);
    } else if (r < 400) {
      r -= 368; int kt = r / 4, nt = r % 4;
      conv_tile(p.in[26] + (size_t)l * 512 * 1024, 1024, kt * 64, nt * 256, wb + W_PA, 512, nt * 256, kt * 64, -1, tile);
    } else if (r < 432) {
      r -= 400; int kt = r / 4, nt = r % 4;
      conv_tile(p.in[27] + (size_t)l * 512 * 1024, 1024, kt * 64, nt * 256, wb + W_PB, 512, nt * 256, kt * 64, -1, tile);
    } else if (r < 496) {
      r -= 432; int kt = r / 4, nt = r % 4;
      conv_tile(p.in[28] + (size_t)l * 1024 * 1024, 1024, kt * 64, nt * 256, wb + W_OUT2, 2048, nt * 256, kt * 64, 1024 + kt * 64, tile);
    } else if (r < 752) {
      r -= 496; int kt = r / 16, nt = r % 16;
      conv_tile(p.in[33] + (size_t)l * 1024 * 4096, 4096, kt * 64, nt * 256, wb + W_UP, 1024, nt * 256, kt * 64, -1, tile);
    } else {
      r -= 752; int kt = r / 4, nt = r % 4;
      conv_tile(p.in[34] + (size_t)l * 4096 * 1024, 1024, kt * 64, nt * 256, wb + W_DN + (size_t)(kt >> 5) * 1024 * 2048, 2048, nt * 256, (kt & 31) * 64, -1, tile);
    }
  }
}

__device__ __forceinline__ void load_row(const float* src, int lane, float4 (&x)[4]) {
#pragma unroll
  for (int i = 0; i < 4; ++i) x[i] = *(const float4*)(src + i * 256 + lane * 4);
}
__device__ __forceinline__ void load_row_bf(const bf16* src, int lane, float4 (&x)[4]) {
#pragma unroll
  for (int i = 0; i < 4; ++i) {
    const uint2 u = *(const uint2*)(src + i * 256 + lane * 4);
    x[i] = make_float4(lo2f(u.x), hi2f(u.x), lo2f(u.y), hi2f(u.y));
  }
}
__device__ __forceinline__ void store_row(float* dst, int lane, const float4 (&x)[4]) {
#pragma unroll
  for (int i = 0; i < 4; ++i) *(float4*)(dst + i * 256 + lane * 4) = x[i];
}
__device__ __forceinline__ float row_ss(const float4 (&x)[4]) {
  float s = 0.f;
#pragma unroll
  for (int i = 0; i < 4; ++i) s += x[i].x * x[i].x + x[i].y * x[i].y + x[i].z * x[i].z + x[i].w * x[i].w;
  return wave_sum(s);
}
__device__ __forceinline__ void emit_u(const P& p, int row, int lane, const float4 (&x)[4], float r, const float* g, const float* win_gate, bool gates) {
  bf16* U = (bf16*)(p.ws + OFF_U) + (size_t)row * 1024;
  float acc[8];
#pragma unroll
  for (int j = 0; j < 8; ++j) acc[j] = 0.f;
#pragma unroll
  for (int i = 0; i < 4; ++i) {
    float4 gg = *(const float4*)(g + i * 256 + lane * 4);
    float u0 = x[i].x * r * gg.x, u1 = x[i].y * r * gg.y, u2 = x[i].z * r * gg.z, u3 = x[i].w * r * gg.w;
    uint2 pk; pk.x = pack2(u0, u1); pk.y = pack2(u2, u3);
    *(uint2*)(U + i * 256 + lane * 4) = pk;
    if (gates) {
      float uu[4] = {u0, u1, u2, u3};
#pragma unroll
      for (int j = 0; j < 4; ++j) {
        const float4* w = (const float4*)(win_gate + (size_t)(i * 256 + lane * 4 + j) * NIN);
        float4 w0 = w[0], w1 = w[1];
        acc[0] += uu[j] * w0.x; acc[1] += uu[j] * w0.y; acc[2] += uu[j] * w0.z; acc[3] += uu[j] * w0.w;
        acc[4] += uu[j] * w1.x; acc[5] += uu[j] * w1.y; acc[6] += uu[j] * w1.z; acc[7] += uu[j] * w1.w;
      }
    }
  }
  if (gates) {
#pragma unroll
    for (int j = 0; j < 8; ++j) acc[j] = wave_sum(acc[j]);
    if (lane == 0) {
      float* G = (float*)(p.ws + OFF_G) + (size_t)row * 8;
      *(float4*)G = make_float4(acc[0], acc[1], acc[2], acc[3]);
      *(float4*)(G + 4) = make_float4(acc[4], acc[5], acc[6], acc[7]);
    }
  }
}

__device__ __forceinline__ const float* init_src(const P& p, int row) {
  return row < ROW_META ? p.in[0] + (size_t)row * 1024
       : row < ROW_S ? p.in[8] + (size_t)((row - ROW_META) & 15) * 1024
                     : p.in[1] + (size_t)(row - ROW_S) * 1024;
}
__device__ __forceinline__ void phase_init_rows(const P& p) {
  const int tid_ = tidx(); const int lane = tid_ & 63, wave = tid_ >> 6;
  for (int row = blockIdx.x * 8 + wave; row < MT; row += gridDim.x * 8) {
    const float* src = row < ROW_META ? p.in[0] + (size_t)row * 1024
                     : row < ROW_S ? p.in[8] + (size_t)((row - ROW_META) & 15) * 1024
                                   : p.in[1] + (size_t)(row - ROW_S) * 1024;
    float4 x[4]; load_row(src, lane, x);
    float r = rsqrtf(row_ss(x) * (1.f / 1024.f) + 1e-6f);
    emit_u(p, row, lane, x, r, p.in[29], p.in[9] + 3840, true);
  }
}

__device__ __forceinline__ void phase_post1(const P& p, int l) {
  const int tid_ = tidx(); const int lane = tid_ & 63, wave = tid_ >> 6;
  const bf16* T = (const bf16*)(p.ws + OFF_T);
  const int stride = gridDim.x * 8;
  int row = blockIdx.x * 8 + wave;
  float4 t[4], x[4];
  if (row < MT) { load_row_bf(T + (size_t)row * 1024, lane, t); load_row(l == 0 ? init_src(p, row) : (const float*)xh_row(p, row), lane, x); }
  while (row < MT) {
    const int nrow = row + stride;
    float4 tn[4], xn[4];
    if (nrow < MT) { load_row_bf(T + (size_t)nrow * 1024, lane, tn); load_row(l == 0 ? init_src(p, nrow) : (const float*)xh_row(p, nrow), lane, xn); }
    float* xr = xh_row(p, row);
    float r = rsqrtf(row_ss(t) * (1.f / 1024.f) + 1e-6f);
#pragma unroll
    for (int i = 0; i < 4; ++i) {
      float4 g = *(const float4*)(p.in[30] + l * 1024 + i * 256 + lane * 4);
      x[i].x += t[i].x * r * g.x; x[i].y += t[i].y * r * g.y; x[i].z += t[i].z * r * g.z; x[i].w += t[i].w * r * g.w;
    }
    store_row(xr, lane, x);
    float r2 = rsqrtf(row_ss(x) * (1.f / 1024.f) + 1e-6f);
    emit_u(p, row, lane, x, r2, p.in[31] + l * 1024, nullptr, false);
    if (nrow < MT) {
#pragma unroll
      for (int i = 0; i < 4; ++i) { t[i] = tn[i]; x[i] = xn[i]; }
    }
    row = nrow;
  }
}
__device__ __forceinline__ void phase_post2(const P& p, int l) {
  const int tid_ = tidx(); const int lane = tid_ & 63, wave = tid_ >> 6;
  const bf16* T = (const bf16*)(p.ws + OFF_T);
  const int stride = gridDim.x * 8;
  int row = blockIdx.x * 8 + wave;
  float4 t[4], x[4];
  if (row < MT) { load_row_bf(T + (size_t)row * 1024, lane, t); load_row(xh_row(p, row), lane, x); }
  while (row < MT) {
    const int nrow = row + stride;
    float4 tn[4], xn[4];
    if (nrow < MT) { load_row_bf(T + (size_t)nrow * 1024, lane, tn); load_row(xh_row(p, nrow), lane, xn); }
    float* xr = xh_row(p, row);
    float r = rsqrtf(row_ss(t) * (1.f / 1024.f) + 1e-6f);
#pragma unroll
    for (int i = 0; i < 4; ++i) {
      float4 g = *(const float4*)(p.in[32] + l * 1024 + i * 256 + lane * 4);
      x[i].x += t[i].x * r * g.x; x[i].y += t[i].y * r * g.y; x[i].z += t[i].z * r * g.z; x[i].w += t[i].w * r * g.w;
    }
    store_row(xr, lane, x);
    if (l == 0) {
      float r2 = rsqrtf(row_ss(x) * (1.f / 1024.f) + 1e-6f);
      emit_u(p, row, lane, x, r2, p.in[29] + 1024, p.in[9] + (size_t)1024 * NIN + 3840, true);
    }
    if (nrow < MT) {
#pragma unroll
      for (int i = 0; i < 4; ++i) { t[i] = tn[i]; x[i] = xn[i]; }
    }
    row = nrow;
  }
}

namespace pg8 {
#define PG8_LAS __attribute__((address_space(3)))
typedef short bf16x8 __attribute__((ext_vector_type(8)));
typedef unsigned u32x4 __attribute__((ext_vector_type(4)));
constexpr int BM = 256, BK = 64, HALF = 128, HTB = HALF * BK * 2, STAGE_BYTES = 8 * HTB, NXCD = 8, WGM = 8;
__device__ __forceinline__ int lds_byte(int r, int c) { const int st = (r >> 4) * 2 + (c >> 5), rr = r & 15, cc = c & 31, ob = rr * 64 + cc * 2; return st * 1024 + (ob ^ (((ob >> 9) & 1) << 5)); }
__device__ __forceinline__ void stage_rc(int b, int& R, int& C) { const int st = b / 1024, sb = b % 1024, swz = sb ^ (((sb >> 9) & 1) << 5); R = (st >> 1) * 16 + swz / 64; C = (st & 1) * 32 + (swz % 64) / 2; }
__device__ __forceinline__ int perm32(int rho) { const int n = rho >> 4, i = rho & 15; return 8 * (i >> 2) + 4 * n + (i & 3); }
struct Unit { int pm, pn; };
struct Gemm { const bf16* A; const bf16* Bt; int K; };
struct StaticOrder {
  int nM, nN, nwg, G, c;
  __device__ void init(int M, int N, int G_, int c_) { nM = M / BM; nN = N / BM; nwg = nM * nN; G = G_; c = c_; }
  __device__ bool next(int i, Unit& u) const {
    const long L = (long)i * G + c; if (L >= nwg) return false;
    int wgid = (int)L; { const int q = nwg / NXCD, r = nwg % NXCD, xcd = wgid % NXCD, off = wgid / NXCD; wgid = (xcd < r ? xcd * (q + 1) : r * (q + 1) + (xcd - r) * q) + off; }
    const int nig = WGM * nN, gid = wgid / nig, fm = gid * WGM, gsz = (nM - fm) < WGM ? (nM - fm) : WGM;
    u.pm = fm + ((wgid % nig) % gsz); u.pn = (wgid % nig) / gsz; return true;
  }
  __device__ __forceinline__ void a_ready(const Unit&) const {}
  __device__ __forceinline__ void done(const Unit&) const {}
};
struct DoneOrder : StaticOrder {
  unsigned* ready;
  __device__ __forceinline__ void done(const Unit& u) const {
    asm volatile("s_waitcnt vmcnt(0)" ::: "memory");
    if ((threadIdx.x & 63) == 0) __hip_atomic_fetch_add(ready + 64 * u.pm, 1u, __ATOMIC_RELAXED, __HIP_MEMORY_SCOPE_AGENT);
  }
};
struct WaitOrder : StaticOrder {
  const unsigned* ready; unsigned need;
  __device__ __forceinline__ void a_ready(const Unit& u) const {
    if (threadIdx.x < 64) {
      unsigned polls = 0;
      while ((unsigned)__builtin_amdgcn_readfirstlane(__hip_atomic_load(ready + 64 * u.pm, __ATOMIC_RELAXED, __HIP_MEMORY_SCOPE_AGENT)) < need) {
        __builtin_amdgcn_s_sleep(2);
        if (++polls > (1u << 21)) break;
      }
      __builtin_amdgcn_fence(__ATOMIC_ACQUIRE, "agent");
      asm volatile("s_waitcnt vmcnt(0)" ::: "memory");
    }
    asm volatile("" ::: "memory"); __builtin_amdgcn_s_barrier(); asm volatile("" ::: "memory");
  }
};
struct UpOrder {
  int G, c, h; unsigned* ready;
  __device__ bool next(int i, Unit& u) const {
    int L;
    if (h < 0 || h > G / 2) { L = c + G * i; if (L >= 552) return false; }
    else if (c < h) { if (i > 0) return false; L = 552 - h + c; }
    else { L = (c - h) + (G - h) * i; if (L >= 552 - h) return false; }
    u.pm = L >> 3; u.pn = L & 7; return true;
  }
  __device__ __forceinline__ void a_ready(const Unit&) const {}
  __device__ __forceinline__ void done(const Unit& u) const {
    asm volatile("s_waitcnt vmcnt(0)" ::: "memory");
    if ((threadIdx.x & 63) == 0) __hip_atomic_fetch_add(ready + 64 * u.pm, 1u, __ATOMIC_RELAXED, __HIP_MEMORY_SCOPE_AGENT);
  }
};
struct DownOrder {
  int G, c, h; const unsigned* ready; unsigned need;
  __device__ bool next(int i, Unit& u) const {
    int L;
    if (h < 0 || h > G / 2) { L = c + G * i; if (L >= 276) return false; }
    else if (c < h) { if (i > 1) return false; L = c + h * i; }
    else { if (i > 0) return false; L = 2 * h + (c - h); }
    u.pm = L >> 2; u.pn = L & 3; return true;
  }
  __device__ __forceinline__ void a_ready(const Unit& u) const {
    if (threadIdx.x < 64) {
      unsigned polls = 0;
      while ((unsigned)__builtin_amdgcn_readfirstlane(__hip_atomic_load(ready + 64 * u.pm, __ATOMIC_RELAXED, __HIP_MEMORY_SCOPE_AGENT)) < need) {
        __builtin_amdgcn_s_sleep(2);
        if (++polls > (1u << 21)) break;
      }
      __builtin_amdgcn_fence(__ATOMIC_ACQUIRE, "agent");
      asm volatile("s_waitcnt vmcnt(0)" ::: "memory");
    }
    asm volatile("" ::: "memory"); __builtin_amdgcn_s_barrier(); asm volatile("" ::: "memory");
  }
  __device__ __forceinline__ void done(const Unit&) const {}
};
struct PairUpOrder {
  int G, c, h;
  __device__ bool next(int i, Unit& u) const {
    int L;
    if (h < 0 || h > G / 2) { L = c + G * i; if (L >= 552) return false; }
    else if (c < h) { if (i > 0) return false; L = 552 - h + c; }
    else { L = (c - h) + (G - h) * i; if (L >= 552 - h) return false; }
    const int pn = L & 7, half = pn >> 2;
    u.pm = half * 69 + (L >> 3); u.pn = pn; return true;
  }
  __device__ __forceinline__ void a_ready(const Unit&) const {}
  __device__ __forceinline__ void done(const Unit&) const {}
};
struct PairOrder {
  int G, c;
  __device__ bool next(int i, Unit& u) const {
    const int L = i * G + c; if (L >= 552) return false;
    const int half = L / 276, r = L % 276;
    u.pm = half * 69 + (r >> 2); u.pn = half * 4 + (r & 3); return true;
  }
  __device__ __forceinline__ void a_ready(const Unit&) const {}
  __device__ __forceinline__ void done(const Unit&) const {}
};
__device__ __forceinline__ unsigned cvt_pk_bf16(float lo, float hi) { unsigned r; asm volatile("v_cvt_pk_bf16_f32 %0, %1, %2" : "=v"(r) : "v"(lo), "v"(hi)); return r; }

template <class Epi, class Sched>
__device__ __forceinline__ void gemm_phase(PG8_LAS unsigned char* lds, const Gemm g, const Sched& S, const Epi& E) {
  const int tid = tidx(), wid = __builtin_amdgcn_readfirstlane(tid >> 6), lane = tid & 63, wr = wid >> 2, wc = wid & 3, fr = lane & 15, fq = lane >> 4;
  const int K = g.K, nt = K / BK;
  unsigned voffA[2], voffB[2];
#pragma unroll
  for (int i = 0; i < 2; ++i) { int R, C; stage_rc(tid * 16 + i * 8192, R, C); const int Rb = Epi::PERM ? ((R & ~31) + perm32(R & 31)) : R;
    voffA[i] = (unsigned)(R * K + C) * 2u; voffB[i] = (unsigned)(Rb * K + C) * 2u; }
  const size_t kstep = (size_t)(BK * 2);
  const size_t hstep = (size_t)HALF * K * 2;
  const size_t tstep = 2 * hstep;
  const unsigned ldsw = (unsigned)wid * 1024u;
  const int aoff = lds_byte(wr * 64 + fr, fq * 8), boff = lds_byte(wc * 32 + fr, fq * 8);
#define PG8_SA(b, h) (((b) * 2 + (h)) * HTB)
#define PG8_SB(b, h) ((4 + (b) * 2 + (h)) * HTB)
#define PG8_STAGE(bufoff, gbase, voff) do { _Pragma("unroll") for (int _i = 0; _i < 2; ++_i) \
    __builtin_amdgcn_global_load_lds((const unsigned*)((const char*)(gbase) + (voff)[_i]), (PG8_LAS unsigned*)(lds + (bufoff) + ldsw + _i * 8192), 16, 0, 0); } while (0)
#define PG8_LDA(dst, b, h) do { _Pragma("unroll") for (int m = 0; m < 4; ++m) _Pragma("unroll") for (int k = 0; k < 2; ++k) dst[m][k] = *(const PG8_LAS bf16x8*)(lds + PG8_SA(b, h) + aoff + m * 2048 + k * 1024); } while (0)
#define PG8_LDB(dst, b, h) do { _Pragma("unroll") for (int n = 0; n < 2; ++n) _Pragma("unroll") for (int k = 0; k < 2; ++k) dst[n][k] = *(const PG8_LAS bf16x8*)(lds + PG8_SB(b, h) + boff + n * 2048 + k * 1024); } while (0)
#define PG8_MMA(ai, bj, At, Bt) do { __builtin_amdgcn_s_setprio(1); _Pragma("unroll") for (int m = 0; m < 4; ++m) _Pragma("unroll") for (int n = 0; n < 2; ++n) _Pragma("unroll") for (int k = 0; k < 2; ++k) \
    acc[ai][bj][m][n] = __builtin_amdgcn_mfma_f32_16x16x32_bf16(__builtin_bit_cast(b8, Bt[n][k]), __builtin_bit_cast(b8, At[m][k]), acc[ai][bj][m][n], 0, 0, 0); __builtin_amdgcn_s_setprio(0); } while (0)
#define PG8_WAIT_V(n) asm volatile("s_waitcnt vmcnt(" #n ")" ::: "memory")
#define PG8_WAIT_L(n) asm volatile("s_waitcnt lgkmcnt(" #n ")" ::: "memory")
#define PG8_BAR __builtin_amdgcn_s_barrier()
#define PG8_SCHED __builtin_amdgcn_sched_barrier(0)
  Unit cur, nxt; int ui = 0;
  if (!S.next(0, cur)) return;
  f32x4 acc[2][2][4][2];
#pragma unroll
  for (int a = 0; a < 2; ++a)
#pragma unroll
    for (int b = 0; b < 2; ++b)
#pragma unroll
      for (int m = 0; m < 4; ++m)
#pragma unroll
        for (int n = 0; n < 2; ++n) acc[a][b][m][n] = (f32x4){0.f, 0.f, 0.f, 0.f};
  bf16x8 At[4][2], B0[2][2], B1[2][2];
  const char* cA = (const char*)g.A + (size_t)cur.pm * tstep; const char* cB = (const char*)g.Bt + (size_t)cur.pn * tstep;
  S.a_ready(cur);
  PG8_STAGE(PG8_SB(0, 0), cB, voffB); PG8_STAGE(PG8_SA(0, 0), cA, voffA); PG8_STAGE(PG8_SB(0, 1), cB + hstep, voffB); PG8_STAGE(PG8_SA(0, 1), cA + hstep, voffA);
  if (wr == 1) PG8_BAR;
  PG8_WAIT_V(4); PG8_BAR;
  PG8_STAGE(PG8_SB(1, 0), cB + kstep, voffB); PG8_STAGE(PG8_SA(1, 0), cA + kstep, voffA); PG8_STAGE(PG8_SB(1, 1), cB + hstep + kstep, voffB);
  PG8_WAIT_V(6); PG8_BAR;
  for (;;) {
    const bool has_next = S.next(ui + 1, nxt);
    const char* nA = has_next ? (const char*)g.A + (size_t)nxt.pm * tstep : cA; const char* nB = has_next ? (const char*)g.Bt + (size_t)nxt.pn * tstep : cB;
    for (int t = 0; t < nt; t += 2) {
      const bool last = (t == nt - 2);
      const char* a1 = cA + (size_t)(t + 1) * kstep;
      const char* a2 = last ? nA : cA + (size_t)(t + 2) * kstep; const char* b2 = last ? nB : cB + (size_t)(t + 2) * kstep;
      const char* a3 = a2 + kstep; const char* b3 = b2 + kstep;
      if (last && has_next) S.a_ready(nxt);
      PG8_LDB(B0, 0, 0); PG8_SCHED; PG8_LDA(At, 0, 0); PG8_STAGE(PG8_SA(1, 1), a1 + hstep, voffA);
      PG8_WAIT_L(8); PG8_BAR; PG8_WAIT_L(0); PG8_MMA(0, 0, At, B0); PG8_BAR; PG8_SCHED;
      PG8_LDB(B1, 0, 1); PG8_STAGE(PG8_SB(0, 0), b2, voffB);
      PG8_BAR; PG8_WAIT_L(0); PG8_MMA(0, 1, At, B1); PG8_BAR;
      PG8_LDA(At, 0, 1); PG8_STAGE(PG8_SA(0, 0), a2, voffA);
      PG8_BAR; PG8_WAIT_L(0); PG8_MMA(1, 0, At, B0); PG8_BAR; PG8_SCHED;
      PG8_STAGE(PG8_SB(0, 1), b2 + hstep, voffB);
      PG8_WAIT_V(6); PG8_BAR; PG8_MMA(1, 1, At, B1); PG8_BAR;
      PG8_LDB(B0, 1, 0); PG8_SCHED; PG8_LDA(At, 1, 0); PG8_STAGE(PG8_SA(0, 1), a2 + hstep, voffA);
      PG8_WAIT_L(8); PG8_BAR; PG8_WAIT_L(0); PG8_MMA(0, 0, At, B0); PG8_BAR; PG8_SCHED;
      PG8_LDB(B1, 1, 1); PG8_STAGE(PG8_SB(1, 0), b3, voffB);
      PG8_BAR; PG8_WAIT_L(0); PG8_MMA(0, 1, At, B1); PG8_BAR;
      PG8_LDA(At, 1, 1); PG8_STAGE(PG8_SA(1, 0), a3, voffA);
      PG8_BAR; PG8_WAIT_L(0); PG8_MMA(1, 0, At, B0); PG8_BAR; PG8_SCHED;
      PG8_STAGE(PG8_SB(1, 1), b3 + hstep, voffB);
      PG8_WAIT_V(6); PG8_BAR; PG8_MMA(1, 1, At, B1); PG8_BAR;
    }
    E(acc, cur, wr, wc, fr, fq);
    S.done(cur);
    if (!has_next) break;
#pragma unroll
    for (int a = 0; a < 2; ++a)
#pragma unroll
      for (int b = 0; b < 2; ++b)
#pragma unroll
        for (int m = 0; m < 4; ++m)
#pragma unroll
          for (int n = 0; n < 2; ++n) acc[a][b][m][n] = (f32x4){0.f, 0.f, 0.f, 0.f};
    cur = nxt; cA = nA; cB = nB; ++ui;
  }
  PG8_WAIT_V(0);
  if (wr == 0) PG8_BAR;
  PG8_BAR;
#undef PG8_SA
#undef PG8_SB
#undef PG8_STAGE
#undef PG8_LDA
#undef PG8_LDB
#undef PG8_MMA
#undef PG8_WAIT_V
#undef PG8_WAIT_L
#undef PG8_BAR
#undef PG8_SCHED
}

template <int ACT> struct EpiB {
  static constexpr bool PERM = true;
  bf16* O; int ldc; int pm_wrap;
  __device__ __forceinline__ void operator()(const f32x4 (&acc)[2][2][4][2], const Unit& u, int wr, int wc, int fr, int fq) const {
    const int pm = u.pm >= pm_wrap ? u.pm - pm_wrap : u.pm;
    const int row0 = pm * BM + wr * 64 + fr, col0 = u.pn * BM + wc * 32 + 8 * fq;
#pragma unroll
    for (int ai = 0; ai < 2; ++ai)
#pragma unroll
      for (int m = 0; m < 4; ++m) {
        bf16* rowp = O + (size_t)(row0 + ai * HALF + m * 16) * ldc + col0;
#pragma unroll
        for (int bj = 0; bj < 2; ++bj) {
          f32x4 v0 = acc[ai][bj][m][0], v1 = acc[ai][bj][m][1];
          if (ACT == 1) {
            const f32x4 z = {0.f, 0.f, 0.f, 0.f};
            v0 = __builtin_elementwise_max(v0, z); v1 = __builtin_elementwise_max(v1, z);
            v0 = v0 * v0; v1 = v1 * v1;
          }
          if (ACT == 3) {
            const uint4 old = *(const uint4*)(rowp + bj * HALF);
            float f[8]; unpack8(old, f);
#pragma unroll
            for (int j = 0; j < 4; ++j) { v0[j] += f[j]; v1[j] += f[4 + j]; }
          }
          if (ACT == 2) {
            const uint4 old = *(const uint4*)(rowp + bj * HALF);
            float f[8]; unpack8(old, f);
#pragma unroll
            for (int j = 0; j < 4; ++j) { v0[j] = sigmoidf(v0[j]) * f[j]; v1[j] = sigmoidf(v1[j]) * f[4 + j]; }
          }
          u32x4 w; w.x = cvt_pk_bf16(v0[0], v0[1]); w.y = cvt_pk_bf16(v0[2], v0[3]); w.z = cvt_pk_bf16(v1[0], v1[1]); w.w = cvt_pk_bf16(v1[2], v1[3]);
          if (ACT == 1 || ACT == 2) {
            bf16* dstp = rowp + bj * HALF;
            asm volatile("global_store_dwordx4 %0, %1, off sc1\n\ts_nop 1" :: "v"(dstp), "v"(w) : "memory");
          } else
          *(u32x4*)(rowp + bj * HALF) = w;
        }
      }
  }
};
template <bool ACCUM> struct EpiF {
  static constexpr bool PERM = false;
  float* C; int ldc;
  __device__ __forceinline__ void operator()(const f32x4 (&acc)[2][2][4][2], const Unit& u, int wr, int wc, int fr, int fq) const {
    const int row0 = u.pm * BM + wr * 64 + fr, col0 = u.pn * BM + wc * 32 + 4 * fq;
#pragma unroll
    for (int ai = 0; ai < 2; ++ai)
#pragma unroll
      for (int m = 0; m < 4; ++m) {
        float* rowp = C + (size_t)(row0 + ai * HALF + m * 16) * ldc + col0;
#pragma unroll
        for (int bj = 0; bj < 2; ++bj)
#pragma unroll
          for (int n = 0; n < 2; ++n) {
            f32x4 v = acc[ai][bj][m][n];
            if (ACCUM) v += *(const f32x4*)(rowp + bj * HALF + n * 16);
            *(f32x4*)(rowp + bj * HALF + n * 16) = v;
          }
      }
  }
};
}

#define LDS3(l) ((PG8_LAS unsigned char*)(l))
__device__ __forceinline__ void phase_gemm_in(const P& p, int l, unsigned char* lds) {
  pg8::Gemm g{(const bf16*)(p.ws + OFF_U), (const bf16*)p.ws + (size_t)l * WBL + W_IN, 1024};
  pg8::StaticOrder S; S.init(MP, ZW, gridDim.x, blockIdx.x);
  pg8::EpiB<0> E{(bf16*)(p.ws + OFF_BIG), ZW, 1 << 20};
  pg8::gemm_phase(LDS3(lds), g, S, E);
}
__device__ __forceinline__ void phase_gemm_v(const P& p, int l, unsigned char* lds) {
  pg8::Gemm g{(const bf16*)(p.ws + OFF_YA), (const bf16*)p.ws + (size_t)l * WBL + W_PA, 512};
  pg8::PairUpOrder S{(int)gridDim.x, (int)blockIdx.x, 276 - (int)gridDim.x};
  pg8::EpiB<0> E{(bf16*)(p.ws + OFF_BIG), 2048, 69};
  pg8::gemm_phase(LDS3(lds), g, S, E);
}
__device__ __forceinline__ void phase_gemm_gate(const P& p, int l, unsigned char* lds) {
  pg8::Gemm g{(const bf16*)(p.ws + OFF_U), (const bf16*)p.ws + (size_t)l * WBL + W_IN + (size_t)3840 * 1024, 1024};
  pg8::UpOrder S; S.G = gridDim.x; S.c = blockIdx.x; S.h = 276 - (int)gridDim.x;
  S.ready = (unsigned*)(p.ws + OFF_CNT) + (size_t)(4 + l) * 69 * 64;
  pg8::EpiB<2> E{(bf16*)(p.ws + OFF_BIG), 2048, 1 << 20};
  pg8::gemm_phase(LDS3(lds), g, S, E);
}
__device__ __forceinline__ void phase_gemm_out(const P& p, int l, unsigned char* lds) {
  pg8::Gemm g{(const bf16*)(p.ws + OFF_BIG), (const bf16*)p.ws + (size_t)l * WBL + W_OUT2, 2048};
  pg8::DownOrder S; S.G = gridDim.x; S.c = blockIdx.x; S.h = 276 - (int)gridDim.x;
  S.ready = (const unsigned*)(p.ws + OFF_CNT) + (size_t)(4 + l) * 69 * 64; S.need = 64u;
  pg8::EpiB<0> E{(bf16*)(p.ws + OFF_T), 1024, 1 << 20};
  pg8::gemm_phase(LDS3(lds), g, S, E);
}
__device__ __forceinline__ void phase_gemm_up(const P& p, int l, int hf, unsigned char* lds) {
  pg8::Gemm g{(const bf16*)(p.ws + OFF_U), (const bf16*)p.ws + (size_t)l * WBL + W_UP + (size_t)hf * 2048 * 1024, 1024};
  pg8::UpOrder S; S.G = gridDim.x; S.c = blockIdx.x; S.h = 276 - (int)gridDim.x;
  S.ready = (unsigned*)(p.ws + OFF_CNT) + (size_t)(l * 2 + hf) * 69 * 64;
  pg8::EpiB<1> E{(bf16*)(p.ws + OFF_BIG), 2048, 1 << 20};
  pg8::gemm_phase(LDS3(lds), g, S, E);
}
__device__ __forceinline__ void phase_gemm_down(const P& p, int l, int hf, unsigned char* lds) {
  pg8::Gemm g{(const bf16*)(p.ws + OFF_BIG), (const bf16*)p.ws + (size_t)l * WBL + W_DN + (size_t)hf * 1024 * 2048, 2048};
  pg8::DownOrder S; S.G = gridDim.x; S.c = blockIdx.x; S.h = 276 - (int)gridDim.x;
  S.ready = (const unsigned*)(p.ws + OFF_CNT) + (size_t)(l * 2 + hf) * 69 * 64; S.need = 64u;
  if (hf) { pg8::EpiB<3> E{(bf16*)(p.ws + OFF_T), 1024, 1 << 20}; pg8::gemm_phase(LDS3(lds), g, S, E); }
  else { pg8::EpiB<0> E{(bf16*)(p.ws + OFF_T), 1024, 1 << 20}; pg8::gemm_phase(LDS3(lds), g, S, E); }
}

constexpr int RTC = 32;
constexpr int RW_R = 0, RW_KR = 8192, RW_V = 16384, RW_DEC = 24576, RW_A = 32768, RW_G = 40960, RW_NKK = 49152,
              RW_KKA = 57344, RW_KP = 65536, RW_YR = 73728, RW_RK = 81920, RW_MU = 82048, RW_AW = 83840, RW_AA = 88448, RW_AG = 93056;

struct RwRegs { uint4 cur[4], prv[4]; };

__device__ __forceinline__ int rw_col(int seg, int h) {
  return seg < 8 ? h * 64 + seg * 8
       : seg < 16 ? 512 + h * 64 + (seg - 8) * 8
       : seg < 24 ? 1024 + h * 64 + (seg - 16) * 8
                  : 1536 + (seg - 24) * 8;
}
__device__ __forceinline__ void rw_issue(const P& p, int tid, int l, int type, int b, int h, int t0, int ntok, RwRegs& rg) {
  const bf16* Z = (const bf16*)(p.ws + OFF_BIG);
#pragma unroll
  for (int i = 0; i < 4; ++i) {
    int vec = tid + NTHR * i;
    rg.cur[i] = make_uint4(0, 0, 0, 0); rg.prv[i] = make_uint4(0, 0, 0, 0);
    if (vec < RTC * 56) {
      int tok = vec / 56, seg = vec % 56;
      if (tok < ntok) {
        int col = rw_col(seg, h);
        int t = t0 + tok;
        rg.cur[i] = *(const uint4*)(Z + (size_t)seq_row(type, b, t) * ZW + col);
        if (t > 0) rg.prv[i] = *(const uint4*)(Z + (size_t)seq_row(type, b, t - 1) * ZW + col);
        else if (type) {
          const float* s = p.in[3] + ((size_t)l * 128 + b) * 1792 + col;
          float f[8];
#pragma unroll
          for (int e = 0; e < 8; ++e) f[e] = s[e];
          rg.prv[i] = pack8(f);
        }
      }
    }
  }
}
__device__ __forceinline__ float fast_tanh(float x) { return 1.f - 2.f * __builtin_amdgcn_rcpf(1.f + __expf(2.f * x)); }

__device__ __forceinline__ void rwkv_item(const P& p, int l, int type, int b, int h, unsigned char* lds0) {
  const int tid = tidx(), lane = tid & 63, wave = tid >> 6;
  const int T = type ? 8 : 2064;
  const int nchunks = type ? 1 : 65;
  const int hc0 = l * 512 + h * 64;

  b8 bw[4];
  {
    const int c = h * 64 + (wave & 3) * 16 + (lane & 15);
    const int q = lane >> 4;
#pragma unroll
    for (int f = 0; f < 4; ++f) {
      const float* src; int kbase;
      if (wave < 4) { src = (f < 2 ? p.in[12] : p.in[14]) + (size_t)l * 64 * 512; kbase = (f & 1) * 32 + q * 8; }
      else { src = p.in[15] + (size_t)l * 128 * 512; kbase = f * 32 + q * 8; }
      float v[8];
#pragma unroll
      for (int e = 0; e < 8; ++e) v[e] = src[(size_t)(kbase + e) * 512 + c];
      uint4 pk = pack8(v);
      bw[f] = __builtin_bit_cast(b8, pk);
    }
  }
  const int cc = (wave & 3) * 16 + (lane & 15);
  const float w0c = p.in[11][hc0 + cc], a0c = p.in[13][hc0 + cc];
  const int c4 = (tid & 15) * 4;
  const float4 kkc = *(const float4*)(p.in[16] + hc0 + c4), kac = *(const float4*)(p.in[17] + hc0 + c4), rkc = *(const float4*)(p.in[18] + hc0 + c4);
  const float4 gnc = *(const float4*)(p.in[19] + hc0 + c4), gbc = *(const float4*)(p.in[20] + hc0 + c4);
  {
    float* MU = (float*)(lds0 + RW_MU);
    if (tid < 448) MU[tid] = p.in[10][l * 1792 + rw_col(tid >> 3, h) + (tid & 7)];
  }
  const int rp = lane >> 4, kq = lane & 15;
  const int ra = wave * 8 + rp * 2, k0 = kq * 4;
  float Sa[4], Sb[4];
  if (type) {
    const float* s0 = p.in[2] + (((size_t)l * 128 + b) * 8 + h) * 4096;
    float4 a = *(const float4*)(s0 + ra * 64 + k0), bq = *(const float4*)(s0 + (ra + 1) * 64 + k0);
    Sa[0] = a.x; Sa[1] = a.y; Sa[2] = a.z; Sa[3] = a.w; Sb[0] = bq.x; Sb[1] = bq.y; Sb[2] = bq.z; Sb[3] = bq.w;
  } else {
#pragma unroll
    for (int j = 0; j < 4; ++j) { Sa[j] = 0.f; Sb[j] = 0.f; }
  }
  RwRegs rg;
  rw_issue(p, tid, l, type, b, h, 0, T < RTC ? T : RTC, rg);
  __syncthreads();

#pragma unroll 1
  for (int c = 0; c < nchunks; ++c) {
    int opq = 0;
    asm volatile("" : "+v"(opq));
    unsigned char* lds = lds0 + opq;
    float* R = (float*)(lds + RW_R); float* KR = (float*)(lds + RW_KR); float* V = (float*)(lds + RW_V);
    float* DEC = (float*)(lds + RW_DEC); float* AA = (float*)(lds + RW_A); float* GG = (float*)(lds + RW_G);
    float* NKK = (float*)(lds + RW_NKK); float* KKA = (float*)(lds + RW_KKA); float* KP = (float*)(lds + RW_KP);
    float* YR = (float*)(lds + RW_YR); float* RK = (float*)(lds + RW_RK); const float* MU = (const float*)(lds + RW_MU);
    bf16* AW = (bf16*)(lds + RW_AW); bf16* AAL = (bf16*)(lds + RW_AA); bf16* AG = (bf16*)(lds + RW_AG);
    const int t0 = c * RTC;
    const int ntok = (T - t0) < RTC ? (T - t0) : RTC;
#pragma unroll
    for (int i = 0; i < 4; ++i) {
      int vec = tid + NTHR * i;
      if (vec < RTC * 56) {
        int tok = vec / 56, seg = vec % 56;
        float zc[8], zp[8], zs[8];
        unpack8(rg.cur[i], zc); unpack8(rg.prv[i], zp);
        float4 m0 = *(const float4*)(MU + seg * 8), m1 = *(const float4*)(MU + seg * 8 + 4);
        float mm[8] = {m0.x, m0.y, m0.z, m0.w, m1.x, m1.y, m1.z, m1.w};
#pragma unroll
        for (int e = 0; e < 8; ++e) zs[e] = zc[e] + (zp[e] - zc[e]) * mm[e];
        if (seg < 24) {
          float* dst = (seg < 8 ? R : seg < 16 ? KR : V) + tok * 64 + (seg & 7) * 8;
          *(float4*)dst = make_float4(zs[0], zs[1], zs[2], zs[3]);
          *(float4*)(dst + 4) = make_float4(zs[4], zs[5], zs[6], zs[7]);
        } else if (seg < 32) {
#pragma unroll
          for (int e = 0; e < 8; ++e) zs[e] = fast_tanh(zs[e]);
          *(uint4*)(AW + tok * 72 + (seg - 24) * 8) = pack8(zs);
        } else if (seg < 40) {
          *(uint4*)(AAL + tok * 72 + (seg - 32) * 8) = pack8(zs);
        } else {
#pragma unroll
          for (int e = 0; e < 8; ++e) zs[e] = sigmoidf(zs[e]);
          *(uint4*)(AG + tok * 136 + (seg - 40) * 8) = pack8(zs);
        }
      }
    }
    __syncthreads();
    {
      const int tokr = lane & 15, q = lane >> 4;
#pragma unroll
      for (int mt = 0; mt < 2; ++mt) {
        const int tr = mt * 16 + tokr;
        if (wave < 4) {
          f32x4 aw = {0, 0, 0, 0}, a2 = {0, 0, 0, 0};
#pragma unroll
          for (int ks = 0; ks < 2; ++ks) {
            b8 x = *(const b8*)(AW + tr * 72 + ks * 32 + q * 8);
            aw = __builtin_amdgcn_mfma_f32_16x16x32_bf16(x, bw[ks], aw, 0, 0, 0);
            b8 y = *(const b8*)(AAL + tr * 72 + ks * 32 + q * 8);
            a2 = __builtin_amdgcn_mfma_f32_16x16x32_bf16(y, bw[2 + ks], a2, 0, 0, 0);
          }
#pragma unroll
          for (int j = 0; j < 4; ++j) {
            int tok = mt * 16 + q * 4 + j;
            float xw = -(w0c + aw[j]);
            float w = -(fmaxf(xw, 0.f) + __logf(1.f + __expf(-fabsf(xw)))) - 0.5f;
            DEC[tok * 64 + cc] = __expf(-__expf(w));
            AA[tok * 64 + cc] = sigmoidf(a0c + a2[j]);
          }
        } else {
          f32x4 ag = {0, 0, 0, 0};
#pragma unroll
          for (int ks = 0; ks < 4; ++ks) {
            b8 x = *(const b8*)(AG + tr * 136 + ks * 32 + q * 8);
            ag = __builtin_amdgcn_mfma_f32_16x16x32_bf16(x, bw[ks], ag, 0, 0, 0);
          }
#pragma unroll
          for (int j = 0; j < 4; ++j) GG[(mt * 16 + q * 4 + j) * 64 + cc] = ag[j];
        }
      }
    }
    __syncthreads();
    {
      const int tok = tid >> 4;
      const float4 kr = *(const float4*)(KR + tok * 64 + c4);
      const float4 av = *(const float4*)(AA + tok * 64 + c4);
      const float4 rv = *(const float4*)(R + tok * 64 + c4);
      float4 kk = make_float4(kr.x * kkc.x, kr.y * kkc.y, kr.z * kkc.z, kr.w * kkc.w);
      float ss = sum16(kk.x * kk.x + kk.y * kk.y + kk.z * kk.z + kk.w * kk.w);
      float inv = rsqrtf(fmaxf(ss, 1e-24f));
      kk.x *= inv; kk.y *= inv; kk.z *= inv; kk.w *= inv;
      float4 kp = make_float4(kr.x * (1.f + (av.x - 1.f) * kac.x), kr.y * (1.f + (av.y - 1.f) * kac.y),
                              kr.z * (1.f + (av.z - 1.f) * kac.z), kr.w * (1.f + (av.w - 1.f) * kac.w));
      *(float4*)(NKK + tok * 64 + c4) = make_float4(-kk.x, -kk.y, -kk.z, -kk.w);
      *(float4*)(KKA + tok * 64 + c4) = make_float4(kk.x * av.x, kk.y * av.y, kk.z * av.z, kk.w * av.w);
      *(float4*)(KP + tok * 64 + c4) = kp;
      float rk = sum16(rv.x * kp.x * rkc.x + rv.y * kp.y * rkc.y + rv.z * kp.z * rkc.z + rv.w * kp.w * rkc.w);
      if ((tid & 15) == 0) RK[tok] = rk;
    }
    __syncthreads();
    if (c + 1 < nchunks) rw_issue(p, tid, l, type, b, h, t0 + RTC, (T - t0 - RTC) < RTC ? (T - t0 - RTC) : RTC, rg);
    {
      float4 nk = *(const float4*)(NKK + k0), ka = *(const float4*)(KKA + k0), kp = *(const float4*)(KP + k0);
      float4 dc = *(const float4*)(DEC + k0), rr = *(const float4*)(R + k0);
      float2 vv = *(const float2*)(V + ra);
#pragma unroll 1
      for (int t = 0; t < ntok; ++t) {
        const int tn = (t + 1 < RTC ? t + 1 : t) * 64;
        const float4 nk2 = *(const float4*)(NKK + tn + k0), ka2 = *(const float4*)(KKA + tn + k0), kp2 = *(const float4*)(KP + tn + k0);
        const float4 dc2 = *(const float4*)(DEC + tn + k0), rr2 = *(const float4*)(R + tn + k0);
        const float2 vv2 = *(const float2*)(V + tn + ra);
        float sa = Sa[0] * nk.x + Sa[1] * nk.y + Sa[2] * nk.z + Sa[3] * nk.w;
        float sb = Sb[0] * nk.x + Sb[1] * nk.y + Sb[2] * nk.z + Sb[3] * nk.w;
        sa = sum16(sa); sb = sum16(sb);
        Sa[0] = Sa[0] * dc.x + (sa * ka.x + vv.x * kp.x);
        Sa[1] = Sa[1] * dc.y + (sa * ka.y + vv.x * kp.y);
        Sa[2] = Sa[2] * dc.z + (sa * ka.z + vv.x * kp.z);
        Sa[3] = Sa[3] * dc.w + (sa * ka.w + vv.x * kp.w);
        Sb[0] = Sb[0] * dc.x + (sb * ka.x + vv.y * kp.x);
        Sb[1] = Sb[1] * dc.y + (sb * ka.y + vv.y * kp.y);
        Sb[2] = Sb[2] * dc.z + (sb * ka.z + vv.y * kp.z);
        Sb[3] = Sb[3] * dc.w + (sb * ka.w + vv.y * kp.w);
        float ya = Sa[0] * rr.x + Sa[1] * rr.y + Sa[2] * rr.z + Sa[3] * rr.w;
        float yb = Sb[0] * rr.x + Sb[1] * rr.y + Sb[2] * rr.z + Sb[3] * rr.w;
        ya = sum16(ya); yb = sum16(yb);
        if (kq == 0) *(float2*)(YR + t * 64 + ra) = make_float2(ya, yb);
        nk = nk2; ka = ka2; kp = kp2; dc = dc2; rr = rr2; vv = vv2;
      }
    }
    __syncthreads();
    {
      const int tok = tid >> 4;
      const float4 y = *(const float4*)(YR + tok * 64 + c4);
      const float4 vv = *(const float4*)(V + tok * 64 + c4);
      const float4 gg = *(const float4*)(GG + tok * 64 + c4);
      float mean = sum16(y.x + y.y + y.z + y.w) * (1.f / 64.f);
      float d0 = y.x - mean, d1 = y.y - mean, d2 = y.z - mean, d3 = y.w - mean;
      float rs = rsqrtf(sum16(d0 * d0 + d1 * d1 + d2 * d2 + d3 * d3) * (1.f / 64.f) + 64e-5f);
      float rk = RK[tok];
      float o0 = (d0 * rs * gnc.x + gbc.x + rk * vv.x) * gg.x;
      float o1 = (d1 * rs * gnc.y + gbc.y + rk * vv.y) * gg.y;
      float o2 = (d2 * rs * gnc.z + gbc.z + rk * vv.z) * gg.z;
      float o3 = (d3 * rs * gnc.w + gbc.w + rk * vv.w) * gg.w;
      if (tok < ntok) {
        bf16* ya = (bf16*)(p.ws + OFF_YA) + (size_t)seq_row(type, b, t0 + tok) * 512 + h * 64 + c4;
        uint2 pk; pk.x = pack2(o0, o1); pk.y = pack2(o2, o3);
        *(uint2*)ya = pk;
      }
    }
    __syncthreads();
  }
  {
    float* so = type ? p.out + O_SS + (((size_t)l * 128 + b) * 8 + h) * 4096 : p.out + O_PS + (((size_t)l * 8 + b) * 8 + h) * 4096;
    *(float4*)(so + ra * 64 + k0) = make_float4(Sa[0], Sa[1], Sa[2], Sa[3]);
    *(float4*)(so + (ra + 1) * 64 + k0) = make_float4(Sb[0], Sb[1], Sb[2], Sb[3]);
  }
}

__device__ __forceinline__ unsigned ld_flag(const unsigned* f) { return __hip_atomic_load(f, __ATOMIC_RELAXED, __HIP_MEMORY_SCOPE_AGENT); }
__device__ __forceinline__ void wait_flag(const unsigned* f, unsigned need) {
  unsigned polls = 0;
  while (ld_flag(f) < need) { __builtin_amdgcn_s_sleep(4); if (++polls > (1u << 22)) break; }
}

__device__ __forceinline__ void rwkv_producer(const P& p, int l, int b, int h, unsigned char* lds0) {
  const int tid = tidx(), lane = tid & 63, wave = tid >> 6;
  const int T = 2064, nchunks = 65, type = 0;
  const int hc0 = l * 512 + h * 64;
  int item_opq = 0; asm volatile("" : "+s"(item_opq));
  const int item = b * 8 + h + item_opq;
  unsigned* flags = (unsigned*)(p.ws + OFF_FLAG) + ((size_t)l * 64 + item) * 64;
  float* ring = (float*)(p.ws + OFF_RING) + (size_t)item * RING_NSLOT * RING_SLOT_F;
  b8 bw[4];
  {
    const int c = h * 64 + (wave & 3) * 16 + (lane & 15);
    const int q = lane >> 4;
#pragma unroll
    for (int f = 0; f < 4; ++f) {
      const float* src; int kbase;
      if (wave < 4) { src = (f < 2 ? p.in[12] : p.in[14]) + (size_t)l * 64 * 512; kbase = (f & 1) * 32 + q * 8; }
      else { src = p.in[15] + (size_t)l * 128 * 512; kbase = f * 32 + q * 8; }
      float v[8];
#pragma unroll
      for (int e = 0; e < 8; ++e) v[e] = src[(size_t)(kbase + e) * 512 + c];
      uint4 pk = pack8(v);
      bw[f] = __builtin_bit_cast(b8, pk);
    }
  }
  const int cc = (wave & 3) * 16 + (lane & 15);
  const float w0c = p.in[11][hc0 + cc], a0c = p.in[13][hc0 + cc];
  const int c4 = (tid & 15) * 4;
  const float4 kkc = *(const float4*)(p.in[16] + hc0 + c4), kac = *(const float4*)(p.in[17] + hc0 + c4), rkc = *(const float4*)(p.in[18] + hc0 + c4);
  {
    float* MU = (float*)(lds0 + RW_MU);
    if (tid < 448) MU[tid] = p.in[10][l * 1792 + rw_col(tid >> 3, h) + (tid & 7)];
  }
  __syncthreads();
  unsigned cf_seen = 0u;
  RwRegs rg;
  rw_issue(p, tid, l, type, b, h, 0, RTC, rg);
#pragma unroll 1
  for (int c = 0; c < nchunks; ++c) {
    int opq = 0;
    asm volatile("" : "+v"(opq));
    unsigned char* lds = lds0 + opq;
    float* R = (float*)(lds + RW_R); float* KR = (float*)(lds + RW_KR); float* V = (float*)(lds + RW_V);
    float* DEC = (float*)(lds + RW_DEC); float* AA = (float*)(lds + RW_A); float* GG = (float*)(lds + RW_G);
    float* NKK = (float*)(lds + RW_NKK); float* KKA = (float*)(lds + RW_KKA); float* KP = (float*)(lds + RW_KP);
    float* RK = (float*)(lds + RW_RK); const float* MU = (const float*)(lds + RW_MU);
    bf16* AW = (bf16*)(lds + RW_AW); bf16* AAL = (bf16*)(lds + RW_AA); bf16* AG = (bf16*)(lds + RW_AG);
    const int t0 = c * RTC;
    if (c >= RING_NSLOT) { if (tid == 0 && cf_seen < (unsigned)(c - RING_NSLOT + 1)) wait_flag(flags + 32, (unsigned)(c - RING_NSLOT + 1)); }
#pragma unroll
    for (int i = 0; i < 4; ++i) {
      int vec = tid + NTHR * i;
      if (vec < RTC * 56) {
        int tok = vec / 56, seg = vec % 56;
        float zc[8], zp[8], zs[8];
        unpack8(rg.cur[i], zc); unpack8(rg.prv[i], zp);
        float4 m0 = *(const float4*)(MU + seg * 8), m1 = *(const float4*)(MU + seg * 8 + 4);
        float mm[8] = {m0.x, m0.y, m0.z, m0.w, m1.x, m1.y, m1.z, m1.w};
#pragma unroll
        for (int e = 0; e < 8; ++e) zs[e] = zc[e] + (zp[e] - zc[e]) * mm[e];
        if (seg < 24) {
          float* dst = (seg < 8 ? R : seg < 16 ? KR : V) + tok * 64 + (seg & 7) * 8;
          *(float4*)dst = make_float4(zs[0], zs[1], zs[2], zs[3]);
          *(float4*)(dst + 4) = make_float4(zs[4], zs[5], zs[6], zs[7]);
        } else if (seg < 32) {
#pragma unroll
          for (int e = 0; e < 8; ++e) zs[e] = fast_tanh(zs[e]);
          *(uint4*)(AW + tok * 72 + (seg - 24) * 8) = pack8(zs);
        } else if (seg < 40) {
          *(uint4*)(AAL + tok * 72 + (seg - 32) * 8) = pack8(zs);
        } else {
#pragma unroll
          for (int e = 0; e < 8; ++e) zs[e] = sigmoidf(zs[e]);
          *(uint4*)(AG + tok * 136 + (seg - 40) * 8) = pack8(zs);
        }
      }
    }
    __syncthreads();
    if (c + 1 < nchunks) rw_issue(p, tid, l, type, b, h, t0 + RTC, (T - t0 - RTC) < RTC ? (T - t0 - RTC) : RTC, rg);
    {
      const int tokr = lane & 15, q = lane >> 4;
#pragma unroll
      for (int mt = 0; mt < 2; ++mt) {
        const int tr = mt * 16 + tokr;
        if (wave < 4) {
          f32x4 aw = {0, 0, 0, 0}, a2 = {0, 0, 0, 0};
#pragma unroll
          for (int ks = 0; ks < 2; ++ks) {
            b8 x = *(const b8*)(AW + tr * 72 + ks * 32 + q * 8);
            aw = __builtin_amdgcn_mfma_f32_16x16x32_bf16(x, bw[ks], aw, 0, 0, 0);
            b8 y = *(const b8*)(AAL + tr * 72 + ks * 32 + q * 8);
            a2 = __builtin_amdgcn_mfma_f32_16x16x32_bf16(y, bw[2 + ks], a2, 0, 0, 0);
          }
#pragma unroll
          for (int j = 0; j < 4; ++j) {
            int tok = mt * 16 + q * 4 + j;
            float xw = -(w0c + aw[j]);
            float w = -(fmaxf(xw, 0.f) + __logf(1.f + __expf(-fabsf(xw)))) - 0.5f;
            DEC[tok * 64 + cc] = __expf(-__expf(w));
            AA[tok * 64 + cc] = sigmoidf(a0c + a2[j]);
          }
        } else {
          f32x4 ag = {0, 0, 0, 0};
#pragma unroll
          for (int ks = 0; ks < 4; ++ks) {
            b8 x = *(const b8*)(AG + tr * 136 + ks * 32 + q * 8);
            ag = __builtin_amdgcn_mfma_f32_16x16x32_bf16(x, bw[ks], ag, 0, 0, 0);
          }
#pragma unroll
          for (int j = 0; j < 4; ++j) GG[(mt * 16 + q * 4 + j) * 64 + cc] = ag[j];
        }
      }
    }
    __syncthreads();
    {
      const int tok = tid >> 4;
      const float4 kr = *(const float4*)(KR + tok * 64 + c4);
      const float4 av = *(const float4*)(AA + tok * 64 + c4);
      const float4 rv = *(const float4*)(R + tok * 64 + c4);
      float4 kk = make_float4(kr.x * kkc.x, kr.y * kkc.y, kr.z * kkc.z, kr.w * kkc.w);
      float ss = sum16(kk.x * kk.x + kk.y * kk.y + kk.z * kk.z + kk.w * kk.w);
      float inv = rsqrtf(fmaxf(ss, 1e-24f));
      kk.x *= inv; kk.y *= inv; kk.z *= inv; kk.w *= inv;
      float4 kp = make_float4(kr.x * (1.f + (av.x - 1.f) * kac.x), kr.y * (1.f + (av.y - 1.f) * kac.y),
                              kr.z * (1.f + (av.z - 1.f) * kac.z), kr.w * (1.f + (av.w - 1.f) * kac.w));
      *(float4*)(NKK + tok * 64 + c4) = make_float4(-kk.x, -kk.y, -kk.z, -kk.w);
      *(float4*)(KKA + tok * 64 + c4) = make_float4(kk.x * av.x, kk.y * av.y, kk.z * av.z, kk.w * av.w);
      *(float4*)(KP + tok * 64 + c4) = kp;
      float rk = sum16(rv.x * kp.x * rkc.x + rv.y * kp.y * rkc.y + rv.z * kp.z * rkc.z + rv.w * kp.w * rkc.w);
      if ((tid & 15) == 0) RK[tok] = rk;
    }
    __syncthreads();
    {
      float* slot = ring + (size_t)(c % RING_NSLOT) * RING_SLOT_F;
#define ST_SC1_F4(dst_, val_) do { float* d_ = (dst_); const float4 t_ = (val_); f32x4 v_ = {t_.x, t_.y, t_.z, t_.w}; asm volatile("global_store_dwordx4 %0, %1, off sc1\n\ts_nop 1" :: "v"(d_), "v"(v_) : "memory"); } while (0)
      ST_SC1_F4(slot + 0 * 2048 + tid * 4, *(const float4*)(R + tid * 4));
      ST_SC1_F4(slot + 1 * 2048 + tid * 4, *(const float4*)(V + tid * 4));
      ST_SC1_F4(slot + 2 * 2048 + tid * 4, *(const float4*)(DEC + tid * 4));
      ST_SC1_F4(slot + 3 * 2048 + tid * 4, *(const float4*)(GG + tid * 4));
      ST_SC1_F4(slot + 4 * 2048 + tid * 4, *(const float4*)(NKK + tid * 4));
      ST_SC1_F4(slot + 5 * 2048 + tid * 4, *(const float4*)(KKA + tid * 4));
      ST_SC1_F4(slot + 6 * 2048 + tid * 4, *(const float4*)(KP + tid * 4));
#undef ST_SC1_F4
      if (tid < 32) { float* d_ = slot + 7 * 2048 + tid; float v_ = RK[tid]; asm volatile("global_store_dword %0, %1, off sc1\n\ts_nop 1" :: "v"(d_), "v"(v_) : "memory"); }
      asm volatile("s_waitcnt vmcnt(0)" ::: "memory");
      __syncthreads();
      if (tid == 0) { __hip_atomic_store(flags, (unsigned)(c + 1), __ATOMIC_RELAXED, __HIP_MEMORY_SCOPE_AGENT); cf_seen = ld_flag(flags + 32); }
    }
  }
  __syncthreads();
}

__device__ __forceinline__ float4 ld_sc1_f4(__amdgpu_buffer_rsrc_t r, unsigned off) {
  pg8::u32x4 v = __builtin_amdgcn_raw_buffer_load_b128(r, off, 0, 16);
  return make_float4(__uint_as_float(v.x), __uint_as_float(v.y), __uint_as_float(v.z), __uint_as_float(v.w));
}
#define CONS_LOAD(slotidx_)                                                                \
  do { const unsigned so_ = (unsigned)(slotidx_) * (unsigned)(RING_SLOT_F * 4) + (unsigned)tid * 16u; \
    cr0 = ld_sc1_f4(rsrc, so_ + 0 * 8192u); cr1 = ld_sc1_f4(rsrc, so_ + 1 * 8192u);       \
    cr2 = ld_sc1_f4(rsrc, so_ + 2 * 8192u); cr3 = ld_sc1_f4(rsrc, so_ + 3 * 8192u);       \
    cr4 = ld_sc1_f4(rsrc, so_ + 4 * 8192u); cr5 = ld_sc1_f4(rsrc, so_ + 5 * 8192u);       \
    cr6 = ld_sc1_f4(rsrc, so_ + 6 * 8192u);                                                \
    crk = __uint_as_float(__builtin_amdgcn_raw_buffer_load_b32(rsrc, (unsigned)(slotidx_) * (unsigned)(RING_SLOT_F * 4) + 7u * 8192u + (unsigned)(tid & 31) * 4u, 0, 16)); } while (0)

__device__ __forceinline__ void rwkv_consumer(const P& p, int l, int b, int h, unsigned char* lds0) {
  const int tid = tidx(), lane = tid & 63, wave = tid >> 6;
  const int T = 2064, nchunks = 65;
  const int hc0 = l * 512 + h * 64;
  int item_opq = 0; asm volatile("" : "+s"(item_opq));
  const int item = b * 8 + h + item_opq;
  unsigned* flags = (unsigned*)(p.ws + OFF_FLAG) + ((size_t)l * 64 + item) * 64;
  const float* ring = (const float*)(p.ws + OFF_RING) + (size_t)item * RING_NSLOT * RING_SLOT_F;
  const int c4 = (tid & 15) * 4;
  const float4 gnc = *(const float4*)(p.in[19] + hc0 + c4), gbc = *(const float4*)(p.in[20] + hc0 + c4);
  const int rp = lane >> 4, kq = lane & 15;
  const int ra = wave * 8 + rp * 2, k0 = kq * 4;
  float Sa[4], Sb[4];
#pragma unroll
  for (int j = 0; j < 4; ++j) { Sa[j] = 0.f; Sb[j] = 0.f; }
  float4 cr0, cr1, cr2, cr3, cr4, cr5, cr6; float crk;
  const __amdgpu_buffer_rsrc_t rsrc = __builtin_amdgcn_make_buffer_rsrc((void*)ring, (short)0, RING_NSLOT * RING_SLOT_F * 4, 0x00020000);
  if (tid == 0) wait_flag(flags, 1u);
  __syncthreads();
  CONS_LOAD(0);
  unsigned fl_seen = 0u;
  if (tid == 0) fl_seen = ld_flag(flags);
#pragma unroll 1
  for (int c = 0; c < nchunks; ++c) {
    int opq = 0;
    asm volatile("" : "+v"(opq));
    unsigned char* lds = lds0 + opq;
    float* R = (float*)(lds + RW_R); float* V = (float*)(lds + RW_V);
    float* DEC = (float*)(lds + RW_DEC); float* GG = (float*)(lds + RW_G);
    float* NKK = (float*)(lds + RW_NKK); float* KKA = (float*)(lds + RW_KKA); float* KP = (float*)(lds + RW_KP);
    float* YR = (float*)(lds + RW_YR); float* RK = (float*)(lds + RW_RK);
    const int t0 = c * RTC;
    const int ntok = (T - t0) < RTC ? (T - t0) : RTC;
    *(float4*)(R + tid * 4) = cr0; *(float4*)(V + tid * 4) = cr1; *(float4*)(DEC + tid * 4) = cr2;
    *(float4*)(GG + tid * 4) = cr3; *(float4*)(NKK + tid * 4) = cr4; *(float4*)(KKA + tid * 4) = cr5;
    *(float4*)(KP + tid * 4) = cr6;
    if (tid < 32) RK[tid] = crk;
    if (tid == 0 && c + 1 < nchunks && fl_seen < (unsigned)(c + 2)) wait_flag(flags, (unsigned)(c + 2));
    __syncthreads();
    if (tid == 0) __hip_atomic_store(flags + 32, (unsigned)(c + 1), __ATOMIC_RELAXED, __HIP_MEMORY_SCOPE_AGENT);
    if (c + 1 < nchunks) CONS_LOAD((c + 1) % RING_NSLOT);
    if (tid == 0) fl_seen = ld_flag(flags);
    {
      const bool odd = (lane & 1) != 0, hi2 = (lane & 2) != 0;
      float sa, sb;
      {
        const float4 nk = *(const float4*)(NKK + k0);
        sa = sum16(Sa[0] * nk.x + Sa[1] * nk.y + Sa[2] * nk.z + Sa[3] * nk.w);
        sb = sum16(Sb[0] * nk.x + Sb[1] * nk.y + Sb[2] * nk.z + Sb[3] * nk.w);
      }
#define RW_LOAD(KA, KP_, DC, RR, NK, VV, tt)                                                         \
      { const int t_ = (tt) < ntok ? (tt) : ntok - 1; const int tn_ = (t_ + 1 < ntok ? t_ + 1 : t_) * 64; \
        KA = *(const float4*)(KKA + t_ * 64 + k0); KP_ = *(const float4*)(KP + t_ * 64 + k0);            \
        DC = *(const float4*)(DEC + t_ * 64 + k0); RR = *(const float4*)(R + t_ * 64 + k0);             \
        NK = *(const float4*)(NKK + tn_ + k0); VV = *(const float2*)(V + t_ * 64 + ra); }
#define RW_STEP(KA, KP_, DC, RR, NK, VV, tt)                                                         \
      { Sa[0] = Sa[0] * DC.x + (sa * KA.x + VV.x * KP_.x); Sa[1] = Sa[1] * DC.y + (sa * KA.y + VV.x * KP_.y); \
        Sa[2] = Sa[2] * DC.z + (sa * KA.z + VV.x * KP_.z); Sa[3] = Sa[3] * DC.w + (sa * KA.w + VV.x * KP_.w); \
        Sb[0] = Sb[0] * DC.x + (sb * KA.x + VV.y * KP_.x); Sb[1] = Sb[1] * DC.y + (sb * KA.y + VV.y * KP_.y); \
        Sb[2] = Sb[2] * DC.z + (sb * KA.z + VV.y * KP_.z); Sb[3] = Sb[3] * DC.w + (sb * KA.w + VV.y * KP_.w); \
        const float pA = Sa[0] * NK.x + Sa[1] * NK.y + Sa[2] * NK.z + Sa[3] * NK.w;                  \
        const float pB = Sb[0] * NK.x + Sb[1] * NK.y + Sb[2] * NK.z + Sb[3] * NK.w;                  \
        const float pC = Sa[0] * RR.x + Sa[1] * RR.y + Sa[2] * RR.z + Sa[3] * RR.w;                  \
        const float pD = Sb[0] * RR.x + Sb[1] * RR.y + Sb[2] * RR.z + Sb[3] * RR.w;                  \
        const float X = (odd ? pB : pA) + dppf<0xB1>(odd ? pA : pB);                                 \
        const float Y = (odd ? pD : pC) + dppf<0xB1>(odd ? pC : pD);                                 \
        float Z = (hi2 ? Y : X) + dppf<0x4E>(hi2 ? X : Y);                                           \
        Z += dppf<0x124>(Z); Z += dppf<0x128>(Z);                                                    \
        sa = dppf<0x00>(Z); sb = dppf<0x55>(Z);                                                      \
        if ((kq & 14) == 2) YR[(tt) * 64 + ra + (kq & 1)] = Z; }
      float4 ka0, kp0, dc0, rr0, nk0, ka1, kp1, dc1, rr1, nk1; float2 vv0, vv1;
      RW_LOAD(ka0, kp0, dc0, rr0, nk0, vv0, 0)
#pragma unroll 1
      for (int t = 0; t < ntok; t += 16) {
        RW_LOAD(ka1, kp1, dc1, rr1, nk1, vv1, t + 1)
        __builtin_amdgcn_sched_barrier(0);
        RW_STEP(ka0, kp0, dc0, rr0, nk0, vv0, t + 0)
        __builtin_amdgcn_sched_barrier(0);
        RW_LOAD(ka0, kp0, dc0, rr0, nk0, vv0, t + 2)
        __builtin_amdgcn_sched_barrier(0);
        RW_STEP(ka1, kp1, dc1, rr1, nk1, vv1, t + 1)
        __builtin_amdgcn_sched_barrier(0);
        RW_LOAD(ka1, kp1, dc1, rr1, nk1, vv1, t + 3)
        __builtin_amdgcn_sched_barrier(0);
        RW_STEP(ka0, kp0, dc0, rr0, nk0, vv0, t + 2)
        __builtin_amdgcn_sched_barrier(0);
        RW_LOAD(ka0, kp0, dc0, rr0, nk0, vv0, t + 4)
        __builtin_amdgcn_sched_barrier(0);
        RW_STEP(ka1, kp1, dc1, rr1, nk1, vv1, t + 3)
        __builtin_amdgcn_sched_barrier(0);
        RW_LOAD(ka1, kp1, dc1, rr1, nk1, vv1, t + 5)
        __builtin_amdgcn_sched_barrier(0);
        RW_STEP(ka0, kp0, dc0, rr0, nk0, vv0, t + 4)
        __builtin_amdgcn_sched_barrier(0);
        RW_LOAD(ka0, kp0, dc0, rr0, nk0, vv0, t + 6)
        __builtin_amdgcn_sched_barrier(0);
        RW_STEP(ka1, kp1, dc1, rr1, nk1, vv1, t + 5)
        __builtin_amdgcn_sched_barrier(0);
        RW_LOAD(ka1, kp1, dc1, rr1, nk1, vv1, t + 7)
        __builtin_amdgcn_sched_barrier(0);
        RW_STEP(ka0, kp0, dc0, rr0, nk0, vv0, t + 6)
        __builtin_amdgcn_sched_barrier(0);
        RW_LOAD(ka0, kp0, dc0, rr0, nk0, vv0, t + 8)
        __builtin_amdgcn_sched_barrier(0);
        RW_STEP(ka1, kp1, dc1, rr1, nk1, vv1, t + 7)
        __builtin_amdgcn_sched_barrier(0);
        RW_LOAD(ka1, kp1, dc1, rr1, nk1, vv1, t + 9)
        __builtin_amdgcn_sched_barrier(0);
        RW_STEP(ka0, kp0, dc0, rr0, nk0, vv0, t + 8)
        __builtin_amdgcn_sched_barrier(0);
        RW_LOAD(ka0, kp0, dc0, rr0, nk0, vv0, t + 10)
        __builtin_amdgcn_sched_barrier(0);
        RW_STEP(ka1, kp1, dc1, rr1, nk1, vv1, t + 9)
        __builtin_amdgcn_sched_barrier(0);
        RW_LOAD(ka1, kp1, dc1, rr1, nk1, vv1, t + 11)
        __builtin_amdgcn_sched_barrier(0);
        RW_STEP(ka0, kp0, dc0, rr0, nk0, vv0, t + 10)
        __builtin_amdgcn_sched_barrier(0);
        RW_LOAD(ka0, kp0, dc0, rr0, nk0, vv0, t + 12)
        __builtin_amdgcn_sched_barrier(0);
        RW_STEP(ka1, kp1, dc1, rr1, nk1, vv1, t + 11)
        __builtin_amdgcn_sched_barrier(0);
        RW_LOAD(ka1, kp1, dc1, rr1, nk1, vv1, t + 13)
        __builtin_amdgcn_sched_barrier(0);
        RW_STEP(ka0, kp0, dc0, rr0, nk0, vv0, t + 12)
        __builtin_amdgcn_sched_barrier(0);
        RW_LOAD(ka0, kp0, dc0, rr0, nk0, vv0, t + 14)
        __builtin_amdgcn_sched_barrier(0);
        RW_STEP(ka1, kp1, dc1, rr1, nk1, vv1, t + 13)
        __builtin_amdgcn_sched_barrier(0);
        RW_LOAD(ka1, kp1, dc1, rr1, nk1, vv1, t + 15)
        __builtin_amdgcn_sched_barrier(0);
        RW_STEP(ka0, kp0, dc0, rr0, nk0, vv0, t + 14)
        __builtin_amdgcn_sched_barrier(0);
        RW_LOAD(ka0, kp0, dc0, rr0, nk0, vv0, t + 16)
        __builtin_amdgcn_sched_barrier(0);
        RW_STEP(ka1, kp1, dc1, rr1, nk1, vv1, t + 15)
        __builtin_amdgcn_sched_barrier(0);
      }
#undef RW_LOAD
#undef RW_STEP
    }
    __syncthreads();
    {
      const int tok = tid >> 4;
      const float4 y = *(const float4*)(YR + tok * 64 + c4);
      const float4 vv = *(const float4*)(V + tok * 64 + c4);
      const float4 gg = *(const float4*)(GG + tok * 64 + c4);
      float mean = sum16(y.x + y.y + y.z + y.w) * (1.f / 64.f);
      float d0 = y.x - mean, d1 = y.y - mean, d2 = y.z - mean, d3 = y.w - mean;
      float rs = rsqrtf(sum16(d0 * d0 + d1 * d1 + d2 * d2 + d3 * d3) * (1.f / 64.f) + 64e-5f);
      float rk = RK[tok];
      float o0 = (d0 * rs * gnc.x + gbc.x + rk * vv.x) * gg.x;
      float o1 = (d1 * rs * gnc.y + gbc.y + rk * vv.y) * gg.y;
      float o2 = (d2 * rs * gnc.z + gbc.z + rk * vv.z) * gg.z;
      float o3 = (d3 * rs * gnc.w + gbc.w + rk * vv.w) * gg.w;
      if (tok < ntok) {
        bf16* ya = (bf16*)(p.ws + OFF_YA) + (size_t)seq_row(0, b, t0 + tok) * 512 + h * 64 + c4;
        uint2 pk; pk.x = pack2(o0, o1); pk.y = pack2(o2, o3);
        *(uint2*)ya = pk;
      }
    }
    __syncthreads();
  }
  {
    float* so = p.out + O_PS + (((size_t)l * 8 + b) * 8 + h) * 4096;
    *(float4*)(so + ra * 64 + k0) = make_float4(Sa[0], Sa[1], Sa[2], Sa[3]);
    *(float4*)(so + (ra + 1) * 64 + k0) = make_float4(Sb[0], Sb[1], Sb[2], Sb[3]);
  }
}

constexpr int ML_Q = 0, ML_K = 17408, ML_K2 = 34816, ML_V = 52224, ML_CB = 69632, ML_AQ = 104448, ML_HS = 113664,
              ML_SG = 149056, ML_SM = 149312, ML_SSC = 149568, ML_SEMT = 149824, ML_SWC = 150080, ML_SNQ = 150336,
              ML_SRD = 150592, ML_SN = 150848, ML_MISC = 151360, ML_CW = 151424, ML_GN = 156544;

__device__ __forceinline__ b8 gather_frag(const bf16* base  ) {
  unsigned w[4];
#pragma unroll
  for (int e = 0; e < 4; ++e) w[e] = (unsigned)base[(2 * e) * 136] | ((unsigned)base[(2 * e + 1) * 136] << 16);
  uint4 pk = make_uint4(w[0], w[1], w[2], w[3]);
  return __builtin_bit_cast(b8, pk);
}

#define ML_PTRS(base)                                                                                                   \
  bf16* Qs = (bf16*)((base) + ML_Q); bf16* Ks = (bf16*)((base) + ML_K); bf16* K2s = (bf16*)((base) + ML_K2);             \
  bf16* Vs = (bf16*)((base) + ML_V); bf16* Cb = (bf16*)((base) + ML_CB); bf16* AQ = (bf16*)((base) + ML_AQ);             \
  float* Hs = (float*)((base) + ML_HS); bf16* RAW = (bf16*)((base) + ML_HS); float* sG = (float*)((base) + ML_SG);       \
  float* sM = (float*)((base) + ML_SM);                                                                                  \
  float* sSC = (float*)((base) + ML_SSC); float* sEMT = (float*)((base) + ML_SEMT); float* sWC = (float*)((base) + ML_SWC); \
  float* sNQ = (float*)((base) + ML_SNQ); float* sRD = (float*)((base) + ML_SRD); float* sN = (float*)((base) + ML_SN);  \
  float* misc = (float*)((base) + ML_MISC); float* CW = (float*)((base) + ML_CW); float* GN = (float*)((base) + ML_GN);  \
  (void)Qs; (void)Ks; (void)K2s; (void)Vs; (void)Cb; (void)AQ; (void)Hs; (void)RAW; (void)sG; (void)sM; (void)sSC;       \
  (void)sEMT; (void)sWC; (void)sNQ; (void)sRD; (void)sN; (void)misc; (void)CW; (void)GN;

struct MlRegs { uint4 raw[5]; };

__device__ __forceinline__ void ml_issue(const P& p, int tid, int l, int type, int b, int h, int tb, int L, MlRegs& rg) {
  const bf16* Z = (const bf16*)(p.ws + OFF_BIG);
#pragma unroll
  for (int i = 0; i < 5; ++i) {
    rg.raw[i] = make_uint4(0, 0, 0, 0);
    const int idx = tid + NTHR * i;
    const int rr = idx >> 5, vq = idx & 31;
    if (rr < L + 3) {
      const int t = tb - 3 + rr;
      const int qc = (vq >> 4) * 512 + h * 128 + (vq & 15) * 8;
      if (t >= 0) rg.raw[i] = *(const uint4*)(Z + (size_t)seq_row(type, b, t) * ZW + 1792 + qc);
      else if (type) {
        const float* cs = p.in[7] + (((size_t)l * 128 + b) * 3 + (t + 3)) * 1024 + qc;
        float f[8];
#pragma unroll
        for (int e = 0; e < 8; ++e) f[e] = cs[e];
        rg.raw[i] = pack8(f);
      }
    }
  }
}

__device__ __forceinline__ void mlstm_item(const P& p, int l, int type, int b, int h, unsigned char* lds) {
  const int tid = tidx(), lane = tid & 63, wave = tid >> 6;
  const int r31 = lane & 31, hh = lane >> 5;
  const bf16* Z = (const bf16*)(p.ws + OFF_BIG);
  const float* G = (const float*)(p.ws + OFF_G);
  const int nchunks = type ? 1 : 33;
  const float ibias = p.in[23][l * 4 + h], fbias = p.in[24][l * 4 + h];

  const int kt = wave >> 1, vt0 = (wave & 1) * 2;
  f32x16 cacc[2];
  MlRegs rg;
  ml_issue(p, tid, l, type, b, h, 0, type ? 8 : 16, rg);
  {
  ML_PTRS(lds)
  if (type) {
    const float* c0 = p.in[4] + (((size_t)l * 128 + b) * 4 + h) * 16384;
#pragma unroll
    for (int x = 0; x < 2; ++x) {
      int v = (vt0 + x) * 32 + r31;
#pragma unroll
      for (int g = 0; g < 4; ++g) {
        float4 q = *(const float4*)(c0 + (size_t)v * 128 + kt * 32 + 8 * g + 4 * hh);
        cacc[x][4 * g] = q.x; cacc[x][4 * g + 1] = q.y; cacc[x][4 * g + 2] = q.z; cacc[x][4 * g + 3] = q.w;
      }
    }
    if (tid < 128) sN[tid] = p.in[5][(((size_t)l * 128 + b) * 4 + h) * 128 + tid];
    if (tid == 0) misc[0] = p.in[6][((size_t)l * 128 + b) * 4 + h];
  } else {
#pragma unroll
    for (int x = 0; x < 2; ++x)
#pragma unroll
      for (int i = 0; i < 16; ++i) cacc[x][i] = 0.f;
    if (tid < 128) sN[tid] = 0.f;
    if (tid == 0) misc[0] = 0.f;
  }
  for (int e = tid; e < 1280; e += NTHR) {
    const int kind = e / 640, r = e % 640, i = r >> 7, c = r & 127;
    const int qc = kind * 512 + h * 128 + c;
    CW[e] = i < 4 ? p.in[21][((size_t)l * 4 + i) * 1024 + qc] : p.in[22][l * 1024 + qc];
  }
  if (tid < 128) GN[tid] = p.in[25][l * 512 + h * 128 + tid];
#pragma unroll
  for (int x = 0; x < 2; ++x) {
    int v = (vt0 + x) * 32 + r31;
#pragma unroll
    for (int g = 0; g < 4; ++g) {
      uint2 pk; pk.x = pack2(cacc[x][4 * g], cacc[x][4 * g + 1]); pk.y = pack2(cacc[x][4 * g + 2], cacc[x][4 * g + 3]);
      *(uint2*)(Cb + v * 136 + kt * 32 + 8 * g + 4 * hh) = pk;
    }
  }
  }
  float g_ig = 0.f, g_fg = 0.f;
  if (wave == 0 && lane < (type ? 8 : 16)) {
    int row = seq_row(type, b, lane);
    g_ig = G[(size_t)row * 8 + h]; g_fg = G[(size_t)row * 8 + 4 + h];
  }
  __syncthreads();

#pragma unroll 1
  for (int c = 0; c < nchunks; ++c) {
    int opq = 0;
    asm volatile("" : "+v"(opq));
    unsigned char* ldsv = lds + opq;
    ML_PTRS(ldsv)
    const int L = type ? 8 : (c == 0 ? 16 : 64);
    const int tb = type ? 0 : (c == 0 ? 0 : 16 + (c - 1) * 64);
    const float m_prev = misc[0];
    if (wave == 0) {
      float lf = 0.f, ig = 0.f;
      if (lane < L) { ig = g_ig + ibias; lf = -softplusf(-(g_fg + fbias)); }
      float bt = lf;
#pragma unroll
      for (int o = 1; o < 64; o <<= 1) { float t = __shfl_up(bt, o); if (lane >= o) bt += t; }
      float g = lane < L ? ig - bt : -INFINITY;
      float pm = g;
#pragma unroll
      for (int o = 1; o < 64; o <<= 1) { float t = __shfl_up(pm, o); if (lane >= o) pm = fmaxf(pm, t); }
      float M = fmaxf(m_prev, pm);
      float ML = __shfl(M, L - 1), btL = __shfl(bt, L - 1);
      sG[lane] = g; sM[lane] = M; sSC[lane] = __expf(m_prev - M); sEMT[lane] = __expf(-(bt + M));
      sWC[lane] = lane < L ? __expf(g - ML) : 0.f;
      if (lane == 0) { misc[1] = __expf(m_prev - ML); misc[2] = btL + ML; }
      if (c + 1 < nchunks) {
        g_ig = 0.f; g_fg = 0.f;
        int row = seq_row(type, b, tb + L + lane);
        g_ig = G[(size_t)row * 8 + h]; g_fg = G[(size_t)row * 8 + 4 + h];
      }
    }
#pragma unroll
    for (int i = 0; i < 5; ++i) {
      const int idx = tid + NTHR * i;
      const int rr = idx >> 5, vq = idx & 31;
      if (rr < 67) *(uint4*)(RAW + rr * 264 + vq * 8) = rg.raw[i];
    }
#pragma unroll
    for (int i = 0; i < 2; ++i) {
      const int idx = tid + NTHR * i;
      const int j = idx >> 4, c0 = (idx & 15) * 8;
      uint4 vv4 = make_uint4(0, 0, 0, 0);
      if (j < L) vv4 = *(const uint4*)(Z + (size_t)seq_row(type, b, tb + j) * ZW + 1792 + 1024 + h * 128 + c0);
      *(uint4*)(Vs + j * 136 + c0) = vv4;
    }
    __syncthreads();
#pragma unroll 1
    for (int it = 0; it < 4; ++it) {
      const int kind = it >> 1;
      const int idx = tid + NTHR * (it & 1);
      const int j = idx >> 4, c0 = (idx & 15) * 8;
      float val[8];
#pragma unroll
      for (int e = 0; e < 8; ++e) val[e] = 0.f;
      if (j < L) {
        const float* cwk = CW + kind * 640 + c0;
        float4 b0 = *(const float4*)(cwk + 512), b1 = *(const float4*)(cwk + 516);
        val[0] = b0.x; val[1] = b0.y; val[2] = b0.z; val[3] = b0.w; val[4] = b1.x; val[5] = b1.y; val[6] = b1.z; val[7] = b1.w;
#pragma unroll
        for (int i = 0; i < 4; ++i) {
          uint4 raw = *(const uint4*)(RAW + (j + i) * 264 + kind * 128 + c0);
          float rv[8]; unpack8(raw, rv);
          float4 w0 = *(const float4*)(cwk + i * 128), w1 = *(const float4*)(cwk + i * 128 + 4);
          val[0] += rv[0] * w0.x; val[1] += rv[1] * w0.y; val[2] += rv[2] * w0.z; val[3] += rv[3] * w0.w;
          val[4] += rv[4] * w1.x; val[5] += rv[5] * w1.y; val[6] += rv[6] * w1.z; val[7] += rv[7] * w1.w;
        }
        const float sc = kind == 1 ? 0.08838834764831845f : 1.f;
#pragma unroll
        for (int e = 0; e < 8; ++e) val[e] = val[e] * sigmoidf(val[e]) * sc;
      }
      if (kind == 0) *(uint4*)(Qs + j * 136 + c0) = pack8(val);
      else {
        *(uint4*)(Ks + j * 136 + c0) = pack8(val);
        float wc = sWC[j];
#pragma unroll
        for (int e = 0; e < 8; ++e) val[e] *= wc;
        *(uint4*)(K2s + j * 136 + c0) = pack8(val);
      }
    }
    __syncthreads();
    if (wave < 4) {
      const int tl = wave >> 1, ts = wave & 1;
      f32x16 acc = {0};
      if (!(tl == 0 && ts == 1)) {
#pragma unroll 2
        for (int ks = 0; ks < 8; ++ks) {
          b8 a = *(const b8*)(Qs + (tl * 32 + r31) * 136 + ks * 16 + hh * 8);
          b8 bb = *(const b8*)(Ks + (ts * 32 + r31) * 136 + ks * 16 + hh * 8);
          acc = __builtin_amdgcn_mfma_f32_32x32x16_bf16(a, bb, acc, 0, 0, 0);
        }
      }
      const int s = ts * 32 + r31;
      const float gs = sG[s];
#pragma unroll
      for (int i = 0; i < 16; ++i) {
        int lr = tl * 32 + (i & 3) + 8 * (i >> 2) + 4 * hh;
        float a = (s <= lr && s < L) ? __expf(gs - sM[lr]) * acc[i] : 0.f;
        AQ[lr * 72 + s] = f2bf(a);
      }
    } else {
      const int t2 = tid - 256, lr = t2 >> 2, part = t2 & 3;
      float s = 0.f;
#pragma unroll
      for (int e8 = 0; e8 < 4; ++e8) {
        uint4 raw = *(const uint4*)(Qs + lr * 136 + part * 32 + e8 * 8);
        float f[8]; unpack8(raw, f);
        float4 n0 = *(const float4*)(sN + part * 32 + e8 * 8), n1 = *(const float4*)(sN + part * 32 + e8 * 8 + 4);
        s += f[0] * n0.x + f[1] * n0.y + f[2] * n0.z + f[3] * n0.w + f[4] * n1.x + f[5] * n1.y + f[6] * n1.z + f[7] * n1.w;
      }
      s += __shfl_xor(s, 1); s += __shfl_xor(s, 2);
      if (part == 0) sNQ[lr] = s;
    }
    __syncthreads();
    {
      const int lr = tid >> 3, part = tid & 7;
      uint4 raw = *(const uint4*)(AQ + lr * 72 + part * 8);
      float f[8]; unpack8(raw, f);
      float s = f[0] + f[1] + f[2] + f[3] + f[4] + f[5] + f[6] + f[7];
      s += __shfl_xor(s, 1); s += __shfl_xor(s, 2); s += __shfl_xor(s, 4);
      if (part == 0) {
        float den = s + sSC[lr] * sNQ[lr];
        sRD[lr] = 1.f / fmaxf(fabsf(den), sEMT[lr]);
      }
    }
    __syncthreads();
    if (c + 1 < nchunks) ml_issue(p, tid, l, type, b, h, tb + L, 64, rg);
    uint4 o0 = make_uint4(0, 0, 0, 0), o1 = make_uint4(0, 0, 0, 0);
    {
      const int lr = tid >> 3, part = tid & 7;
      if (lr < L) {
        const bf16* zo = Z + (size_t)seq_row(type, b, tb + lr) * ZW + 1792 + 1536 + h * 128 + part * 16;
        o0 = *(const uint4*)zo; o1 = *(const uint4*)(zo + 8);
      }
    }
    {
      const int li = wave >> 2, vi = wave & 3;
      f32x16 acc = {0};
#pragma unroll 2
      for (int ks = 0; ks < 8; ++ks) {
        b8 a = *(const b8*)(Qs + (li * 32 + r31) * 136 + ks * 16 + hh * 8);
        b8 bb = *(const b8*)(Cb + (vi * 32 + r31) * 136 + ks * 16 + hh * 8);
        acc = __builtin_amdgcn_mfma_f32_32x32x16_bf16(a, bb, acc, 0, 0, 0);
      }
#pragma unroll
      for (int i = 0; i < 16; ++i) acc[i] *= sSC[li * 32 + (i & 3) + 8 * (i >> 2) + 4 * hh];
#pragma unroll 1
      for (int ks = 0; ks < 4; ++ks) {
        b8 a = *(const b8*)(AQ + (li * 32 + r31) * 72 + ks * 16 + hh * 8);
        b8 bb = gather_frag(Vs + (ks * 16 + hh * 8) * 136 + vi * 32 + r31);
        acc = __builtin_amdgcn_mfma_f32_32x32x16_bf16(a, bb, acc, 0, 0, 0);
      }
#pragma unroll
      for (int i = 0; i < 16; ++i) {
        int lr = li * 32 + (i & 3) + 8 * (i >> 2) + 4 * hh;
        Hs[lr * 132 + vi * 32 + r31] = acc[i] * sRD[lr];
      }
      if (tid < 128) {
        float s0 = 0.f, s1 = 0.f, s2 = 0.f, s3 = 0.f;
#pragma unroll 4
        for (int j = 0; j < 64; j += 4) {
          s0 += bf2f(K2s[j * 136 + tid]); s1 += bf2f(K2s[(j + 1) * 136 + tid]);
          s2 += bf2f(K2s[(j + 2) * 136 + tid]); s3 += bf2f(K2s[(j + 3) * 136 + tid]);
        }
        sN[tid] = misc[1] * sN[tid] + ((s0 + s1) + (s2 + s3));
      }
    }
    __syncthreads();
    {
      const int lr = tid >> 3, part = tid & 7;
      float x[16];
#pragma unroll
      for (int q = 0; q < 4; ++q) {
        float4 v = *(const float4*)(Hs + lr * 132 + part * 16 + q * 4);
        x[4 * q] = v.x; x[4 * q + 1] = v.y; x[4 * q + 2] = v.z; x[4 * q + 3] = v.w;
      }
      float s = 0.f;
#pragma unroll
      for (int e = 0; e < 16; ++e) s += x[e];
      s += __shfl_xor(s, 1); s += __shfl_xor(s, 2); s += __shfl_xor(s, 4);
      float mean = s * (1.f / 128.f);
      float vs = 0.f;
#pragma unroll
      for (int e = 0; e < 16; ++e) { x[e] -= mean; vs += x[e] * x[e]; }
      vs += __shfl_xor(vs, 1); vs += __shfl_xor(vs, 2); vs += __shfl_xor(vs, 4);
      float rs = rsqrtf(vs * (1.f / 128.f) + 1e-5f);
      if (lr < L) {
        int row = seq_row(type, b, tb + lr);
        bf16* yb = (bf16*)(p.ws + OFF_YB) + (size_t)row * 512 + h * 128 + part * 16;
        {
          float of[8], y[8]; unpack8(o0, of);
#pragma unroll
          for (int e = 0; e < 8; ++e) y[e] = x[e] * rs * GN[part * 16 + e] * sigmoidf(of[e]);
          *(uint4*)yb = pack8(y);
        }
        {
          float of[8], y[8]; unpack8(o1, of);
#pragma unroll
          for (int e = 0; e < 8; ++e) y[e] = x[8 + e] * rs * GN[part * 16 + 8 + e] * sigmoidf(of[e]);
          *(uint4*)(yb + 8) = pack8(y);
        }
      }
      __builtin_amdgcn_sched_barrier(0);
      const float dec = misc[1];
#pragma unroll
      for (int x2 = 0; x2 < 2; ++x2)
#pragma unroll
        for (int i = 0; i < 16; ++i) cacc[x2][i] *= dec;
#pragma unroll 1
      for (int ks = 0; ks < 4; ++ks) {
        b8 a = gather_frag(K2s + (ks * 16 + hh * 8) * 136 + kt * 32 + r31);
#pragma unroll
        for (int x2 = 0; x2 < 2; ++x2) {
          b8 bb = gather_frag(Vs + (ks * 16 + hh * 8) * 136 + (vt0 + x2) * 32 + r31);
          cacc[x2] = __builtin_amdgcn_mfma_f32_32x32x16_bf16(a, bb, cacc[x2], 0, 0, 0);
        }
      }
#pragma unroll
      for (int x2 = 0; x2 < 2; ++x2) {
        int v = (vt0 + x2) * 32 + r31;
#pragma unroll
        for (int g = 0; g < 4; ++g) {
          uint2 pk; pk.x = pack2(cacc[x2][4 * g], cacc[x2][4 * g + 1]); pk.y = pack2(cacc[x2][4 * g + 2], cacc[x2][4 * g + 3]);
          *(uint2*)(Cb + v * 136 + kt * 32 + 8 * g + 4 * hh) = pk;
        }
      }
      if (tid == 0) misc[0] = misc[2];
    }
    __syncthreads();
  }
  {
    ML_PTRS(lds)
    const size_t sidx = type ? ((size_t)l * 128 + b) * 4 + h : ((size_t)l * 8 + b) * 4 + h;
    float* co = p.out + (type ? O_SC : O_PC) + sidx * 16384;
#pragma unroll
    for (int x = 0; x < 2; ++x) {
      int v = (vt0 + x) * 32 + r31;
#pragma unroll
      for (int g = 0; g < 4; ++g)
        *(float4*)(co + (size_t)v * 128 + kt * 32 + 8 * g + 4 * hh) =
            make_float4(cacc[x][4 * g], cacc[x][4 * g + 1], cacc[x][4 * g + 2], cacc[x][4 * g + 3]);
    }
    if (tid < 128) p.out[(type ? O_SN : O_PN) + sidx * 128 + tid] = sN[tid];
    if (tid == 0) p.out[(type ? O_SM : O_PM) + sidx] = misc[0];
  }
  __syncthreads();
}

__device__ __forceinline__ void phase_mixers(const P& p, int l, unsigned char* lds) {
  const int nb = gridDim.x, bid = blockIdx.x;
  {
    const bf16* Z = (const bf16*)(p.ws + OFF_BIG);
    const int total = 136 * 4864;
    const int tid = tidx();
    for (int i = bid * NTHR + tid; i < total; i += nb * NTHR) {
      int sq = i / 4864, e = i % 4864;
      int type = sq >= 8, b = type ? sq - 8 : sq;
      int T = type ? 8 : 2064;
      if (e < 1792) {
        float v = bf2f(Z[(size_t)seq_row(type, b, T - 1) * ZW + e]);
        if (type) p.out[O_SSH + ((size_t)l * 128 + b) * 1792 + e] = v; else p.out[O_PSH + ((size_t)l * 8 + b) * 1792 + e] = v;
      } else {
        int e2 = e - 1792, j = e2 >> 10, cc = e2 & 1023;
        float v = bf2f(Z[(size_t)seq_row(type, b, T - 3 + j) * ZW + 1792 + cc]);
        if (type) p.out[O_SCV + (((size_t)l * 128 + b) * 3 + j) * 1024 + cc] = v; else p.out[O_PCV + (((size_t)l * 8 + b) * 3 + j) * 1024 + cc] = v;
      }
    }
  }
  const int BIGN = 1 << 24;
  int r0 = BIGN, rs = BIGN, m0 = BIGN, ms = BIGN, role = 0;
  if (nb >= 224) {
    if (bid < 64) role = 1;
    else if (bid < 96) { m0 = bid - 64; }
    else if (bid < 160) role = 2;
    else { r0 = 64 + (bid - 160); rs = nb - 160; m0 = 32 + (bid - 160); ms = nb - 160; }
  } else { r0 = bid; rs = nb; m0 = bid; ms = nb; }
#ifndef NO_CONS
  if (role == 1) rwkv_consumer(p, l, bid >> 3, bid & 7, lds);
#endif
#ifndef NO_PROD
  if (role == 2) rwkv_producer(p, l, (bid - 96) >> 3, (bid - 96) & 7, lds);
#endif
  if (role == 0) {
#pragma unroll 1
    for (int it = r0; it < 64 + 1024; it += rs) { int type = it >= 64, x = type ? it - 64 : it; rwkv_item(p, l, type, x >> 3, x & 7, lds); }
#pragma unroll 1
    for (int it = m0; it < 32 + 512; it += ms) { int type = it >= 32, x = type ? it - 32 : it; mlstm_item(p, l, type, x >> 2, x & 3, lds); }
  }
}

#define XB_TMO      128
#define XB_XCNT(j)  (256  + 64 * (j))
#define XB_XSUB(j)  (1280 + 64 * (j))
#define XB_XGEN(j)  (2304 + 64 * (j))
#define XB_TOP      3328
#define XB_TOPGEN   3392
#define XCD_BAR_WORDS 3456
#define XB_SPIN_CAP (1u << 20)
__device__ __forceinline__ unsigned xb_ld(unsigned* p)              { return __hip_atomic_load(p, __ATOMIC_RELAXED, __HIP_MEMORY_SCOPE_AGENT); }
__device__ __forceinline__ unsigned xb_add(unsigned* p, unsigned v) { return __hip_atomic_fetch_add(p, v, __ATOMIC_RELAXED, __HIP_MEMORY_SCOPE_AGENT); }
__device__ __forceinline__ unsigned xb_xcc_id() { return (unsigned)__builtin_amdgcn_s_getreg((3 << 11) | 20) & 0xFu; }
#define XB_SPIN(cond, bar) do { unsigned _sp = 0; while (cond) { __builtin_amdgcn_s_sleep(1); \
    if ((++_sp & 255u) == 0u) { if (xb_ld(&(bar)[XB_TMO])) break; if (_sp > XB_SPIN_CAP) { atomicAdd(&(bar)[XB_TMO], 1u); break; } } } } while (0)
struct XcdBarrier { unsigned* bar; unsigned x; volatile PG8_LAS unsigned* st; };
__device__ __forceinline__ XcdBarrier xcd_barrier_post(unsigned* bar, volatile PG8_LAS unsigned* st) {
  XcdBarrier b; b.bar = bar; b.x = xb_xcc_id(); b.st = st;
  if (threadIdx.x == 0) (void)xb_add(&bar[XB_XCNT(b.x)], 1u);
  return b;
}
__device__ __forceinline__ void xcd_barrier_complete(unsigned* bar, unsigned x, unsigned& nloc, unsigned& nx) {
  const unsigned G = gridDim.x * gridDim.y * gridDim.z;
  unsigned sum, cnt, mine, sp = 0u;
  for (;;) {
    sum = 0u; cnt = 0u; mine = 0u;
#pragma unroll
    for (unsigned j = 0; j < 16; ++j) { const unsigned c = xb_ld(&bar[XB_XCNT(j)]); sum += c; cnt += (c > 0u) ? 1u : 0u; mine = (j == x) ? c : mine; }
    if (sum == G) break;
    __builtin_amdgcn_s_sleep(1);
    if ((++sp & 255u) == 0u) { if (xb_ld(&bar[XB_TMO])) break; if (sp > XB_SPIN_CAP) { atomicAdd(&bar[XB_TMO], 1u); break; } }
  }
  nloc = mine > 0u ? mine : 1u; nx = cnt > 0u ? cnt : 1u;
}
__device__ __forceinline__ void xcd_barrier(const XcdBarrier& b) {
  asm volatile("s_waitcnt vmcnt(0)" ::: "memory");
  __syncthreads();
  if (threadIdx.x == 0) {
    unsigned* bar = b.bar;
    __builtin_amdgcn_s_waitcnt(0);
    unsigned nloc = b.st[0], nx = b.st[1];
    if (nloc == 0u) { xcd_barrier_complete(bar, b.x, nloc, nx); b.st[0] = nloc; b.st[1] = nx; }
    const unsigned old = xb_add(&bar[XB_XSUB(b.x)], 1u);
    const unsigned gen = old / nloc;
    if (old + 1u == (gen + 1u) * nloc) {
      __builtin_amdgcn_fence(__ATOMIC_RELEASE, "agent");
      asm volatile("s_waitcnt vmcnt(0)" ::: "memory");
      const unsigned og = xb_add(&bar[XB_TOP], 1u);
      const unsigned tg = og / nx;
      if (og + 1u == (tg + 1u) * nx) xb_add(&bar[XB_TOPGEN], 1u);
      else XB_SPIN(xb_ld(&bar[XB_TOPGEN]) == tg, bar);
      __builtin_amdgcn_fence(__ATOMIC_ACQUIRE, "agent");
      xb_add(&bar[XB_XGEN(b.x)], 1u);
      asm volatile("s_waitcnt vmcnt(0)" ::: "memory");
    } else {
      XB_SPIN(xb_ld(&bar[XB_XGEN(b.x)]) == gen, bar);
      __builtin_amdgcn_fence(__ATOMIC_ACQUIRE, "agent");
      asm volatile("s_waitcnt vmcnt(0)" ::: "memory");
    }
  }
  __syncthreads();
}

__global__ void __launch_bounds__(NTHR) __attribute__((target("no-packed-fp32-ops"))) mega(P p) {
  extern __shared__ __attribute__((aligned(16))) unsigned char lds[];
  cg::grid_group grid = cg::this_grid();
  volatile PG8_LAS unsigned* xst = (volatile PG8_LAS unsigned*)(LDS3(lds) + (LDS_BYTES - 16));
  if (threadIdx.x == 0) { xst[0] = 0u; xst[1] = 0u; }
  __syncthreads();
  const XcdBarrier xb = xcd_barrier_post((unsigned*)(p.ws + OFF_BAR), xst);
#ifndef ONLY
#define ONLY 0xFFFF
#endif
  if (blockIdx.x == 0) { unsigned* fl = (unsigned*)(p.ws + OFF_FLAG); for (int i = threadIdx.x; i < 2 * 64 * 64; i += NTHR) fl[i] = 0u; }
  if (ONLY & 1) phase_convert(p, lds);
  if (ONLY & 2) phase_init_rows(p);
  if (p.ws == nullptr) grid.sync();
  xcd_barrier(xb);
#pragma unroll 1
  for (int l = 0; l < 2; ++l) {
    if (ONLY & 4) phase_gemm_in(p, l, lds);
    xcd_barrier(xb);
#ifndef MIXREP
#define MIXREP 1
#endif
#pragma unroll 1
    for (int rep = 0; rep < MIXREP; ++rep) {
#ifndef REPMODE
#define REPMODE 3
#endif
      if (ONLY & 8) phase_mixers(p, l, lds);
      xcd_barrier(xb);
    }
    if (ONLY & 16) phase_gemm_v(p, l, lds);
    if (ONLY & 16) phase_gemm_gate(p, l, lds);
    if (ONLY & 32) phase_gemm_out(p, l, lds);
    xcd_barrier(xb);
    if (ONLY & 64) phase_post1(p, l);
    xcd_barrier(xb);
#pragma unroll 1
    for (int hf = 0; hf < 2; ++hf) {
      if (ONLY & 128) phase_gemm_up(p, l, hf, lds);
      if (ONLY & 256) phase_gemm_down(p, l, hf, lds);
      xcd_barrier(xb);
    }
    if (ONLY & 512) phase_post2(p, l);
    if (l == 0) xcd_barrier(xb);
  }
}

extern "C" void kernel_launch(void* const* d_in, const int* in_sizes, int n_in, void* d_out, int out_size,
                              void* d_ws, size_t ws_size, hipStream_t stream) {
  static int grid_blocks = 0;
  if (!grid_blocks) {
    if (n_in != 35 || (size_t)out_size != O_END || ws_size < WS_END) {
      fprintf(stderr, "kernel_launch: unexpected sizes n_in=%d out=%d ws=%zu (need %zu)\n", n_in, out_size, ws_size, (size_t)WS_END);
      grid_blocks = -1; return;
    }
    int dev = 0, cus = 0, per_cu = 0;
    (void)hipGetDevice(&dev);
    (void)hipDeviceGetAttribute(&cus, hipDeviceAttributeMultiprocessorCount, dev);
    (void)hipFuncSetAttribute((const void*)mega, hipFuncAttributeMaxDynamicSharedMemorySize, LDS_BYTES);
    (void)hipOccupancyMaxActiveBlocksPerMultiprocessor(&per_cu, (const void*)mega, NTHR, LDS_BYTES);
    if (per_cu < 1) per_cu = 1;
    grid_blocks = cus * per_cu;
  }
  if (grid_blocks < 0) return;
  P p{};
  for (int i = 0; i < 35; ++i) p.in[i] = (const float*)d_in[i];
  p.out = (float*)d_out; p.ws = (unsigned char*)d_ws;
  (void)hipMemsetAsync((unsigned char*)d_ws + OFF_BAR, 0, 16384 + 110592, stream);
  void* args[] = {&p};
  hipError_t e = hipLaunchCooperativeKernel((void*)mega, dim3(grid_blocks), dim3(NTHR), args, LDS_BYTES, stream);
  if (e != hipSuccess) fprintf(stderr, "cooperative launch failed: %s (grid %d)\n", hipGetErrorString(e), grid_blocks);
}
```

```cpp
#include <hip/hip_runtime.h>
#include <hip/hip_cooperative_groups.h>
#include <cstdio>
#include <cstdint>
namespace cg = cooperative_groups;

typedef unsigned short bf16;
typedef __attribute__((ext_vector_type(8))) __bf16 b8;
typedef __attribute__((ext_vector_type(16))) float f32x16;
typedef __attribute__((ext_vector_type(4))) float f32x4;

constexpr int MT = 17536;
constexpr int ROW_META = 16384;
constexpr int ROW_S = 16512;
constexpr int ZW = 3840;
constexpr int NIN = 5896;
constexpr int NTHR = 512;

constexpr size_t O_YS = 16777216;
constexpr size_t O_PS = O_YS + 1048576;
constexpr size_t O_PSH = O_PS + 524288;
constexpr size_t O_PC = O_PSH + 28672;
constexpr size_t O_PN = O_PC + 1048576;
constexpr size_t O_PM = O_PN + 8192;
constexpr size_t O_PCV = O_PM + 64;
constexpr size_t O_SS = O_PCV + 49152;
constexpr size_t O_SSH = O_SS + 8388608;
constexpr size_t O_SC = O_SSH + 458752;
constexpr size_t O_SN = O_SC + 16777216;
constexpr size_t O_SM = O_SN + 131072;
constexpr size_t O_SCV = O_SM + 1024;
constexpr size_t O_END = O_SCV + 786432;

constexpr int MP = 17664;
constexpr size_t W_IN = 0, W_PA = 6029312, W_PB = 6553600, W_OUT2 = 7077888, W_UP = 9175040, W_DN = 13369344;
constexpr size_t WBL = 17563648;
constexpr size_t OFF_META = 2 * WBL * 2;
constexpr size_t OFF_U = OFF_META + 524288;
constexpr size_t OFF_BIG = OFF_U + (size_t)MP * 1024 * 2;
constexpr size_t OFF_T = OFF_BIG + (size_t)MP * 2048 * 2;
constexpr size_t OFF_YA = OFF_BIG + (size_t)MP * 2048 * 2 + (size_t)MP * 1024 * 4;
constexpr size_t OFF_YB = OFF_YA + (size_t)MP * 512 * 2;
constexpr size_t OFF_G = OFF_YB + (size_t)MP * 512 * 2;
constexpr size_t OFF_FLAG = OFF_G + (size_t)MT * 8 * 4;
constexpr size_t OFF_RING = OFF_FLAG + 2 * 64 * 256;
constexpr int RING_SLOT_F = 7 * 2048 + 32;
constexpr int RING_NSLOT = 4;
constexpr size_t OFF_BAR = OFF_RING + (size_t)64 * RING_NSLOT * RING_SLOT_F * 4;
constexpr size_t OFF_CNT = OFF_BAR + 16384;
constexpr size_t WS_END = OFF_CNT + 110592;

constexpr int LDS_BYTES = 157184;

struct P {
  const float* in[35];
  float* out;
  unsigned char* ws;
};

__device__ __forceinline__ bf16 f2bf(float f) {
  unsigned u = __float_as_uint(f);
  u += 0x7FFFu + ((u >> 16) & 1u);
  return (bf16)(u >> 16);
}
__device__ __forceinline__ float bf2f(bf16 h) { return __uint_as_float(((unsigned)h) << 16); }
__device__ __forceinline__ unsigned pack2(float a, float b) { return (unsigned)f2bf(a) | ((unsigned)f2bf(b) << 16); }
__device__ __forceinline__ float lo2f(unsigned u) { return __uint_as_float(u << 16); }
__device__ __forceinline__ float hi2f(unsigned u) { return __uint_as_float(u & 0xFFFF0000u); }
__device__ __forceinline__ void unpack8(const uint4& v, float* f) {
  f[0] = lo2f(v.x); f[1] = hi2f(v.x); f[2] = lo2f(v.y); f[3] = hi2f(v.y);
  f[4] = lo2f(v.z); f[5] = hi2f(v.z); f[6] = lo2f(v.w); f[7] = hi2f(v.w);
}
__device__ __forceinline__ uint4 pack8(const float* f) {
  uint4 v; v.x = pack2(f[0], f[1]); v.y = pack2(f[2], f[3]); v.z = pack2(f[4], f[5]); v.w = pack2(f[6], f[7]); return v;
}
__device__ __forceinline__ float sigmoidf(float x) { return __builtin_amdgcn_rcpf(1.f + __expf(-x)); }
__device__ __forceinline__ float softplusf(float x) { return fmaxf(x, 0.f) + log1pf(__expf(-fabsf(x))); }
__device__ __forceinline__ float wave_sum(float v) {
#pragma unroll
  for (int o = 32; o; o >>= 1) v += __shfl_xor(v, o);
  return v;
}
template <int CTRL> __device__ __forceinline__ float dppf(float v) {
  return __int_as_float(__builtin_amdgcn_update_dpp(0, __float_as_int(v), CTRL, 0xF, 0xF, true));
}
__device__ __forceinline__ float sum16(float v) {
  v += dppf<0xB1>(v);
  v += dppf<0x4E>(v);
  v += dppf<0x141>(v);
  v += dppf<0x140>(v);
  return v;
}
__device__ __forceinline__ float* xh_row(const P& p, int r) {
  if (r < ROW_META) return p.out + (size_t)r * 1024;
  if (r < ROW_S) return (float*)(p.ws + OFF_META) + (size_t)(r - ROW_META) * 1024;
  return p.out + O_YS + (size_t)(r - ROW_S) * 1024;
}
__device__ __forceinline__ int seq_row(int type, int b, int t) {
  if (type) return ROW_S + b * 8 + t;
  return t < 16 ? ROW_META + b * 16 + t : b * 2048 + t - 16;
}
__device__ __forceinline__ int tidx() { int t = threadIdx.x; asm volatile("" : "+v"(t)); return t; }
__device__ __forceinline__ b8 ldsfrag(const unsigned char* p) { return *(const b8*)p; }

__device__ __forceinline__ void conv_tile(const float* __restrict__ src, int ld, int k0, int sc0, bf16* __restrict__ dst, int K, int dn0, int dk0, int dk1, float* tile) {
  const int tid = tidx();
  float4 v[8];
#pragma unroll
  for (int i = 0; i < 8; ++i) {
    int idx = tid + NTHR * i; int k = idx >> 6, n4 = (idx & 63) * 4;
    v[i] = *(const float4*)(src + (size_t)(k0 + k) * ld + sc0 + n4);
  }
#pragma unroll
  for (int i = 0; i < 8; ++i) {
    int idx = tid + NTHR * i; int k = idx >> 6, n4 = (idx & 63) * 4;
    float* t = tile + k * 257 + n4;
    t[0] = v[i].x; t[1] = v[i].y; t[2] = v[i].z; t[3] = v[i].w;
  }
  __syncthreads();
#pragma unroll
  for (int i = 0; i < 4; ++i) {
    int idx = tid + NTHR * i; int kc = idx >> 8, n = idx & 255;
    float f[8];
#pragma unroll
    for (int e = 0; e < 8; ++e) f[e] = tile[(kc * 8 + e) * 257 + n];
    uint4 pk = pack8(f);
    *(uint4*)(dst + (size_t)(dn0 + n) * K + dk0 + kc * 8) = pk;
    if (dk1 >= 0) *(uint4*)(dst + (size_t)(dn0 + n) * K + dk1 + kc * 8) = pk;
  }
  __syncthreads();
}

__device__ __forceinline__ void phase_convert(const P& p, unsigned char* lds) {
  float* tile = (float*)lds;
  for (int t = blockIdx.x; t < 2016; t += gridDim.x) {
    int l = t / 1008, r = t % 1008;
    bf16* wb = (bf16*)p.ws + (size_t)l * WBL;
    if (r < 368) {
      int kt = r / 23, nt = r % 23;
      conv_tile(p.in[9] + (size_t)l * 1024 * NIN, NIN, kt * 64, nt * 256 + (nt >= 15 ? 8 : 0), wb + W_IN, 1024, nt * 256, kt * 64, -1, tile);
    } else if (r < 400) {
      r -= 368; int kt = r / 4, nt = r % 4;
      conv_tile(p.in[26] + (size_t)l * 512 * 1024, 1024, kt * 64, nt * 256, wb + W_PA, 512, nt * 256, kt * 64, -1, tile);
    } else if (r < 432) {
      r -= 400; int kt = r / 4, nt = r % 4;
      conv_tile(p.in[27] + (size_t)l * 512 * 1024, 1024, kt * 64, nt * 256, wb + W_PB, 512, nt * 256, kt * 64, -1, tile);
    } else if (r < 496) {
      r -= 432; int kt = r / 4, nt = r % 4;
      conv_tile(p.in[28] + (size_t)l * 1024 * 1024, 1024, kt * 64, nt * 256, wb + W_OUT2, 2048, nt * 256, kt * 64, 1024 + kt * 64, tile);
    } else if (r < 752) {
      r -= 496; int kt = r / 16, nt = r % 16;
      conv_tile(p.in[33] + (size_t)l * 1024 * 4096, 4096, kt * 64, nt * 256, wb + W_UP, 1024, nt * 256, kt * 64, -1, tile);
    } else {
      r -= 752; int kt = r / 4, nt = r % 4;
      conv_tile(p.in[34] + (size_t)l * 4096 * 1024, 1024, kt * 64, nt * 256, wb + W_DN + (size_t)(kt >> 5) * 1024 * 2048, 2048, nt * 256, (kt & 31) * 64, -1, tile);
    }
  }
}

__device__ __forceinline__ void load_row(const float* src, int lane, float4 (&x)[4]) {
#pragma unroll
  for (int i = 0; i < 4; ++i) x[i] = *(const float4*)(src + i * 256 + lane * 4);
}
__device__ __forceinline__ void load_row_bf(const bf16* src, int lane, float4 (&x)[4]) {
#pragma unroll
  for (int i = 0; i < 4; ++i) {
    const uint2 u = *(const uint2*)(src + i * 256 + lane * 4);
    x[i] = make_float4(lo2f(u.x), hi2f(u.x), lo2f(u.y), hi2f(u.y));
  }
}
__device__ __forceinline__ void store_row(float* dst, int lane, const float4 (&x)[4]) {
#pragma unroll
  for (int i = 0; i < 4; ++i) *(float4*)(dst + i * 256 + lane * 4) = x[i];
}
__device__ __forceinline__ float row_ss(const float4 (&x)[4]) {
  float s = 0.f;
#pragma unroll
  for (int i = 0; i < 4; ++i) s += x[i].x * x[i].x + x[i].y * x[i].y + x[i].z * x[i].z + x[i].w * x[i].w;
  return wave_sum(s);
}
__device__ __forceinline__ void emit_u(const P& p, int row, int lane, const float4 (&x)[4], float r, const float* g, const float* win_gate, bool gates) {
  bf16* U = (bf16*)(p.ws + OFF_U) + (size_t)row * 1024;
  float acc[8];
#pragma unroll
  for (int j = 0; j < 8; ++j) acc[j] = 0.f;
#pragma unroll
  for (int i = 0; i < 4; ++i) {
    float4 gg = *(const float4*)(g + i * 256 + lane * 4);
    float u0 = x[i].x * r * gg.x, u1 = x[i].y * r * gg.y, u2 = x[i].z * r * gg.z, u3 = x[i].w * r * gg.w;
    uint2 pk; pk.x = pack2(u0, u1); pk.y = pack2(u2, u3);
    *(uint2*)(U + i * 256 + lane * 4) = pk;
    if (gates) {
      float uu[4] = {u0, u1, u2, u3};
#pragma unroll
      for (int j = 0; j < 4; ++j) {
        const float4* w = (const float4*)(win_gate + (size_t)(i * 256 + lane * 4 + j) * NIN);
        float4 w0 = w[0], w1 = w[1];
        acc[0] += uu[j] * w0.x; acc[1] += uu[j] * w0.y; acc[2] += uu[j] * w0.z; acc[3] += uu[j] * w0.w;
        acc[4] += uu[j] * w1.x; acc[5] += uu[j] * w1.y; acc[6] += uu[j] * w1.z; acc[7] += uu[j] * w1.w;
      }
    }
  }
  if (gates) {
#pragma unroll
    for (int j = 0; j < 8; ++j) acc[j] = wave_sum(acc[j]);
    if (lane == 0) {
      float* G = (float*)(p.ws + OFF_G) + (size_t)row * 8;
      *(float4*)G = make_float4(acc[0], acc[1], acc[2], acc[3]);
      *(float4*)(G + 4) = make_float4(acc[4], acc[5], acc[6], acc[7]);
    }
  }
}

__device__ __forceinline__ const float* init_src(const P& p, int row) {
  return row < ROW_META ? p.in[0] + (size_t)row * 1024
       : row < ROW_S ? p.in[8] + (size_t)((row - ROW_META) & 15) * 1024
                     : p.in[1] + (size_t)(row - ROW_S) * 1024;
}
__device__ __forceinline__ void phase_init_rows(const P& p) {
  const int tid_ = tidx(); const int lane = tid_ & 63, wave = tid_ >> 6;
  for (int row = blockIdx.x * 8 + wave; row < MT; row += gridDim.x * 8) {
    const float* src = row < ROW_META ? p.in[0] + (size_t)row * 1024
                     : row < ROW_S ? p.in[8] + (size_t)((row - ROW_META) & 15) * 1024
                                   : p.in[1] + (size_t)(row - ROW_S) * 1024;
    float4 x[4]; load_row(src, lane, x);
    float r = rsqrtf(row_ss(x) * (1.f / 1024.f) + 1e-6f);
    emit_u(p, row, lane, x, r, p.in[29], p.in[9] + 3840, true);
  }
}

__device__ __forceinline__ void phase_post1(const P& p, int l) {
  const int tid_ = tidx(); const int lane = tid_ & 63, wave = tid_ >> 6;
  const bf16* T = (const bf16*)(p.ws + OFF_T);
  const int stride = gridDim.x * 8;
  int row = blockIdx.x * 8 + wave;
  float4 t[4], x[4];
  if (row < MT) { load_row_bf(T + (size_t)row * 1024, lane, t); load_row(l == 0 ? init_src(p, row) : (const float*)xh_row(p, row), lane, x); }
  while (row < MT) {
    const int nrow = row + stride;
    float4 tn[4], xn[4];
    if (nrow < MT) { load_row_bf(T + (size_t)nrow * 1024, lane, tn); load_row(l == 0 ? init_src(p, nrow) : (const float*)xh_row(p, nrow), lane, xn); }
    float* xr = xh_row(p, row);
    float r = rsqrtf(row_ss(t) * (1.f / 1024.f) + 1e-6f);
#pragma unroll
    for (int i = 0; i < 4; ++i) {
      float4 g = *(const float4*)(p.in[30] + l * 1024 + i * 256 + lane * 4);
      x[i].x += t[i].x * r * g.x; x[i].y += t[i].y * r * g.y; x[i].z += t[i].z * r * g.z; x[i].w += t[i].w * r * g.w;
    }
    store_row(xr, lane, x);
    float r2 = rsqrtf(row_ss(x) * (1.f / 1024.f) + 1e-6f);
    emit_u(p, row, lane, x, r2, p.in[31] + l * 1024, nullptr, false);
    if (nrow < MT) {
#pragma unroll
      for (int i = 0; i < 4; ++i) { t[i] = tn[i]; x[i] = xn[i]; }
    }
    row = nrow;
  }
}
__device__ __forceinline__ void phase_post2(const P& p, int l) {
  const int tid_ = tidx(); const int lane = tid_ & 63, wave = tid_ >> 6;
  const bf16* T = (const bf16*)(p.ws + OFF_T);
  const int stride = gridDim.x * 8;
  int row = blockIdx.x * 8 + wave;
  float4 t[4], x[4];
  const bf16* T2 = T + (size_t)MP * 1024;
#define LOAD_T2(dst_, row_) do { float4 tb_[4]; load_row_bf(T + (size_t)(row_) * 1024, lane, dst_); load_row_bf(T2 + (size_t)(row_) * 1024, lane, tb_); \
    _Pragma("unroll") for (int i_ = 0; i_ < 4; ++i_) { dst_[i_].x += tb_[i_].x; dst_[i_].y += tb_[i_].y; dst_[i_].z += tb_[i_].z; dst_[i_].w += tb_[i_].w; } } while (0)
  if (row < MT) { LOAD_T2(t, row); load_row(xh_row(p, row), lane, x); }
  while (row < MT) {
    const int nrow = row + stride;
    float4 tn[4], xn[4];
    if (nrow < MT) { LOAD_T2(tn, nrow); load_row(xh_row(p, nrow), lane, xn); }
    float* xr = xh_row(p, row);
    float r = rsqrtf(row_ss(t) * (1.f / 1024.f) + 1e-6f);
#pragma unroll
    for (int i = 0; i < 4; ++i) {
      float4 g = *(const float4*)(p.in[32] + l * 1024 + i * 256 + lane * 4);
      x[i].x += t[i].x * r * g.x; x[i].y += t[i].y * r * g.y; x[i].z += t[i].z * r * g.z; x[i].w += t[i].w * r * g.w;
    }
    store_row(xr, lane, x);
    if (l == 0) {
      float r2 = rsqrtf(row_ss(x) * (1.f / 1024.f) + 1e-6f);
      emit_u(p, row, lane, x, r2, p.in[29] + 1024, p.in[9] + (size_t)1024 * NIN + 3840, true);
    }
    if (nrow < MT) {
#pragma unroll
      for (int i = 0; i < 4; ++i) { t[i] = tn[i]; x[i] = xn[i]; }
    }
    row = nrow;
  }
}

namespace pg8 {
#define PG8_LAS __attribute__((address_space(3)))
typedef short bf16x8 __attribute__((ext_vector_type(8)));
typedef unsigned u32x4 __attribute__((ext_vector_type(4)));
constexpr int BM = 256, BK = 64, HALF = 128, HTB = HALF * BK * 2, STAGE_BYTES = 8 * HTB, NXCD = 8, WGM = 8;
__device__ __forceinline__ int lds_byte(int r, int c) { const int st = (r >> 4) * 2 + (c >> 5), rr = r & 15, cc = c & 31, ob = rr * 64 + cc * 2; return st * 1024 + (ob ^ (((ob >> 9) & 1) << 5)); }
__device__ __forceinline__ void stage_rc(int b, int& R, int& C) { const int st = b / 1024, sb = b % 1024, swz = sb ^ (((sb >> 9) & 1) << 5); R = (st >> 1) * 16 + swz / 64; C = (st & 1) * 32 + (swz % 64) / 2; }
__device__ __forceinline__ int perm32(int rho) { const int n = rho >> 4, i = rho & 15; return 8 * (i >> 2) + 4 * n + (i & 3); }
struct Unit { int pm, pn; };
struct Gemm { const bf16* A; const bf16* Bt; int K; };
struct StaticOrder {
  int nM, nN, nwg, G, c;
  __device__ void init(int M, int N, int G_, int c_) { nM = M / BM; nN = N / BM; nwg = nM * nN; G = G_; c = c_; }
  __device__ bool next(int i, Unit& u) const {
    const long L = (long)i * G + c; if (L >= nwg) return false;
    int wgid = (int)L; { const int q = nwg / NXCD, r = nwg % NXCD, xcd = wgid % NXCD, off = wgid / NXCD; wgid = (xcd < r ? xcd * (q + 1) : r * (q + 1) + (xcd - r) * q) + off; }
    const int nig = WGM * nN, gid = wgid / nig, fm = gid * WGM, gsz = (nM - fm) < WGM ? (nM - fm) : WGM;
    u.pm = fm + ((wgid % nig) % gsz); u.pn = (wgid % nig) / gsz; return true;
  }
  __device__ __forceinline__ void a_ready(const Unit&) const {}
  __device__ __forceinline__ void done(const Unit&) const {}
};
struct DoneOrder : StaticOrder {
  unsigned* ready;
  __device__ __forceinline__ void done(const Unit& u) const {
    asm volatile("s_waitcnt vmcnt(0)" ::: "memory");
    if ((threadIdx.x & 63) == 0) __hip_atomic_fetch_add(ready + 64 * u.pm, 1u, __ATOMIC_RELAXED, __HIP_MEMORY_SCOPE_AGENT);
  }
};
struct WaitOrder : StaticOrder {
  const unsigned* ready; unsigned need;
  __device__ __forceinline__ void a_ready(const Unit& u) const {
    if (threadIdx.x < 64) {
      unsigned polls = 0;
      while ((unsigned)__builtin_amdgcn_readfirstlane(__hip_atomic_load(ready + 64 * u.pm, __ATOMIC_RELAXED, __HIP_MEMORY_SCOPE_AGENT)) < need) {
        __builtin_amdgcn_s_sleep(2);
        if (++polls > (1u << 21)) break;
      }
      __builtin_amdgcn_fence(__ATOMIC_ACQUIRE, "agent");
      asm volatile("s_waitcnt vmcnt(0)" ::: "memory");
    }
    asm volatile("" ::: "memory"); __builtin_amdgcn_s_barrier(); asm volatile("" ::: "memory");
  }
};
struct UpOrder {
  int G, c, h; unsigned* ready;
  __device__ bool next(int i, Unit& u) const {
    int L;
    if (h < 0 || h > G / 2) { L = c + G * i; if (L >= 552) return false; }
    else if (c < h) { if (i > 0) return false; L = 552 - h + c; }
    else { L = (c - h) + (G - h) * i; if (L >= 552 - h) return false; }
    u.pm = L >> 3; u.pn = L & 7; return true;
  }
  __device__ __forceinline__ void a_ready(const Unit&) const {}
  __device__ __forceinline__ void done(const Unit& u) const {
    asm volatile("s_waitcnt vmcnt(0)" ::: "memory");
    if ((threadIdx.x & 63) == 0) __hip_atomic_fetch_add(ready + 64 * u.pm, 1u, __ATOMIC_RELAXED, __HIP_MEMORY_SCOPE_AGENT);
  }
};
struct DownOrder {
  int G, c, h; const unsigned* ready; unsigned need;
  __device__ bool next(int i, Unit& u) const {
    int L;
    if (h < 0 || h > G / 2) { L = c + G * i; if (L >= 276) return false; }
    else if (c < h) { if (i > 1) return false; L = c + h * i; }
    else { if (i > 0) return false; L = 2 * h + (c - h); }
    u.pm = L >> 2; u.pn = L & 3; return true;
  }
  __device__ __forceinline__ void a_ready(const Unit& u) const {
    if (threadIdx.x < 64) {
      unsigned polls = 0;
      while ((unsigned)__builtin_amdgcn_readfirstlane(__hip_atomic_load(ready + 64 * u.pm, __ATOMIC_RELAXED, __HIP_MEMORY_SCOPE_AGENT)) < need) {
        __builtin_amdgcn_s_sleep(2);
        if (++polls > (1u << 21)) break;
      }
      __builtin_amdgcn_fence(__ATOMIC_ACQUIRE, "agent");
      asm volatile("s_waitcnt vmcnt(0)" ::: "memory");
    }
    asm volatile("" ::: "memory"); __builtin_amdgcn_s_barrier(); asm volatile("" ::: "memory");
  }
  __device__ __forceinline__ void done(const Unit&) const {}
};
struct PairUpOrder {
  int G, c, h;
  __device__ bool next(int i, Unit& u) const {
    int L;
    if (h < 0 || h > G / 2) { L = c + G * i; if (L >= 552) return false; }
    else if (c < h) { if (i > 0) return false; L = 552 - h + c; }
    else { L = (c - h) + (G - h) * i; if (L >= 552 - h) return false; }
    const int pn = L & 7, half = pn >> 2;
    u.pm = half * 69 + (L >> 3); u.pn = pn; return true;
  }
  __device__ __forceinline__ void a_ready(const Unit&) const {}
  __device__ __forceinline__ void done(const Unit&) const {}
};
struct PairOrder {
  int G, c;
  __device__ bool next(int i, Unit& u) const {
    const int L = i * G + c; if (L >= 552) return false;
    const int half = L / 276, r = L % 276;
    u.pm = half * 69 + (r >> 2); u.pn = half * 4 + (r & 3); return true;
  }
  __device__ __forceinline__ void a_ready(const Unit&) const {}
  __device__ __forceinline__ void done(const Unit&) const {}
};
__device__ __forceinline__ unsigned cvt_pk_bf16(float lo, float hi) { unsigned r; asm volatile("v_cvt_pk_bf16_f32 %0, %1, %2" : "=v"(r) : "v"(lo), "v"(hi)); return r; }

template <class Epi, class Sched>
__device__ __forceinline__ void gemm_phase(PG8_LAS unsigned char* lds, const Gemm g, const Sched& S, const Epi& E) {
  const int tid = tidx(), wid = __builtin_amdgcn_readfirstlane(tid >> 6), lane = tid & 63, wr = wid >> 2, wc = wid & 3, fr = lane & 15, fq = lane >> 4;
  const int K = g.K, nt = K / BK;
  unsigned voffA[2], voffB[2];
#pragma unroll
  for (int i = 0; i < 2; ++i) { int R, C; stage_rc(tid * 16 + i * 8192, R, C); const int Rb = Epi::PERM ? ((R & ~31) + perm32(R & 31)) : R;
    voffA[i] = (unsigned)(R * K + C) * 2u; voffB[i] = (unsigned)(Rb * K + C) * 2u; }
  const size_t kstep = (size_t)(BK * 2);
  const size_t hstep = (size_t)HALF * K * 2;
  const size_t tstep = 2 * hstep;
  const unsigned ldsw = (unsigned)wid * 1024u;
  const int aoff = lds_byte(wr * 64 + fr, fq * 8), boff = lds_byte(wc * 32 + fr, fq * 8);
#define PG8_SA(b, h) (((b) * 2 + (h)) * HTB)
#define PG8_SB(b, h) ((4 + (b) * 2 + (h)) * HTB)
#define PG8_STAGE(bufoff, gbase, voff) do { _Pragma("unroll") for (int _i = 0; _i < 2; ++_i) \
    __builtin_amdgcn_global_load_lds((const unsigned*)((const char*)(gbase) + (voff)[_i]), (PG8_LAS unsigned*)(lds + (bufoff) + ldsw + _i * 8192), 16, 0, 0); } while (0)
#define PG8_LDA(dst, b, h) do { _Pragma("unroll") for (int m = 0; m < 4; ++m) _Pragma("unroll") for (int k = 0; k < 2; ++k) dst[m][k] = *(const PG8_LAS bf16x8*)(lds + PG8_SA(b, h) + aoff + m * 2048 + k * 1024); } while (0)
#define PG8_LDB(dst, b, h) do { _Pragma("unroll") for (int n = 0; n < 2; ++n) _Pragma("unroll") for (int k = 0; k < 2; ++k) dst[n][k] = *(const PG8_LAS bf16x8*)(lds + PG8_SB(b, h) + boff + n * 2048 + k * 1024); } while (0)
#define PG8_MMA(ai, bj, At, Bt) do { __builtin_amdgcn_s_setprio(1); _Pragma("unroll") for (int m = 0; m < 4; ++m) _Pragma("unroll") for (int n = 0; n < 2; ++n) _Pragma("unroll") for (int k = 0; k < 2; ++k) \
    acc[ai][bj][m][n] = __builtin_amdgcn_mfma_f32_16x16x32_bf16(__builtin_bit_cast(b8, Bt[n][k]), __builtin_bit_cast(b8, At[m][k]), acc[ai][bj][m][n], 0, 0, 0); __builtin_amdgcn_s_setprio(0); } while (0)
#define PG8_WAIT_V(n) asm volatile("s_waitcnt vmcnt(" #n ")" ::: "memory")
#define PG8_WAIT_L(n) asm volatile("s_waitcnt lgkmcnt(" #n ")" ::: "memory")
#define PG8_BAR __builtin_amdgcn_s_barrier()
#define PG8_SCHED __builtin_amdgcn_sched_barrier(0)
  Unit cur, nxt; int ui = 0;
  if (!S.next(0, cur)) return;
  f32x4 acc[2][2][4][2];
#pragma unroll
  for (int a = 0; a < 2; ++a)
#pragma unroll
    for (int b = 0; b < 2; ++b)
#pragma unroll
      for (int m = 0; m < 4; ++m)
#pragma unroll
        for (int n = 0; n < 2; ++n) acc[a][b][m][n] = (f32x4){0.f, 0.f, 0.f, 0.f};
  bf16x8 At[4][2], B0[2][2], B1[2][2];
  const char* cA = (const char*)g.A + (size_t)cur.pm * tstep; const char* cB = (const char*)g.Bt + (size_t)cur.pn * tstep;
  S.a_ready(cur);
  PG8_STAGE(PG8_SB(0, 0), cB, voffB); PG8_STAGE(PG8_SA(0, 0), cA, voffA); PG8_STAGE(PG8_SB(0, 1), cB + hstep, voffB); PG8_STAGE(PG8_SA(0, 1), cA + hstep, voffA);
  if (wr == 1) PG8_BAR;
  PG8_WAIT_V(4); PG8_BAR;
  PG8_STAGE(PG8_SB(1, 0), cB + kstep, voffB); PG8_STAGE(PG8_SA(1, 0), cA + kstep, voffA); PG8_STAGE(PG8_SB(1, 1), cB + hstep + kstep, voffB);
  PG8_WAIT_V(6); PG8_BAR;
  for (;;) {
    const bool has_next = S.next(ui + 1, nxt);
    const char* nA = has_next ? (const char*)g.A + (size_t)nxt.pm * tstep : cA; const char* nB = has_next ? (const char*)g.Bt + (size_t)nxt.pn * tstep : cB;
    for (int t = 0; t < nt; t += 2) {
      const bool last = (t == nt - 2);
      const char* a1 = cA + (size_t)(t + 1) * kstep;
      const char* a2 = last ? nA : cA + (size_t)(t + 2) * kstep; const char* b2 = last ? nB : cB + (size_t)(t + 2) * kstep;
      const char* a3 = a2 + kstep; const char* b3 = b2 + kstep;
      if (last && has_next) S.a_ready(nxt);
      PG8_LDB(B0, 0, 0); PG8_SCHED; PG8_LDA(At, 0, 0); PG8_STAGE(PG8_SA(1, 1), a1 + hstep, voffA);
      PG8_WAIT_L(8); PG8_BAR; PG8_WAIT_L(0); PG8_MMA(0, 0, At, B0); PG8_BAR; PG8_SCHED;
      PG8_LDB(B1, 0, 1); PG8_STAGE(PG8_SB(0, 0), b2, voffB);
      PG8_BAR; PG8_WAIT_L(0); PG8_MMA(0, 1, At, B1); PG8_BAR;
      PG8_LDA(At, 0, 1); PG8_STAGE(PG8_SA(0, 0), a2, voffA);
      PG8_BAR; PG8_WAIT_L(0); PG8_MMA(1, 0, At, B0); PG8_BAR; PG8_SCHED;
      PG8_STAGE(PG8_SB(0, 1), b2 + hstep, voffB);
      PG8_WAIT_V(6); PG8_BAR; PG8_MMA(1, 1, At, B1); PG8_BAR;
      PG8_LDB(B0, 1, 0); PG8_SCHED; PG8_LDA(At, 1, 0); PG8_STAGE(PG8_SA(0, 1), a2 + hstep, voffA);
      PG8_WAIT_L(8); PG8_BAR; PG8_WAIT_L(0); PG8_MMA(0, 0, At, B0); PG8_BAR; PG8_SCHED;
      PG8_LDB(B1, 1, 1); PG8_STAGE(PG8_SB(1, 0), b3, voffB);
      PG8_BAR; PG8_WAIT_L(0); PG8_MMA(0, 1, At, B1); PG8_BAR;
      PG8_LDA(At, 1, 1); PG8_STAGE(PG8_SA(1, 0), a3, voffA);
      PG8_BAR; PG8_WAIT_L(0); PG8_MMA(1, 0, At, B0); PG8_BAR; PG8_SCHED;
      PG8_STAGE(PG8_SB(1, 1), b3 + hstep, voffB);
      PG8_WAIT_V(6); PG8_BAR; PG8_MMA(1, 1, At, B1); PG8_BAR;
    }
    E(acc, cur, wr, wc, fr, fq);
    S.done(cur);
    if (!has_next) break;
#pragma unroll
    for (int a = 0; a < 2; ++a)
#pragma unroll
      for (int b = 0; b < 2; ++b)
#pragma unroll
        for (int m = 0; m < 4; ++m)
#pragma unroll
          for (int n = 0; n < 2; ++n) acc[a][b][m][n] = (f32x4){0.f, 0.f, 0.f, 0.f};
    cur = nxt; cA = nA; cB = nB; ++ui;
  }
  PG8_WAIT_V(0);
  if (wr == 0) PG8_BAR;
  PG8_BAR;
#undef PG8_SA
#undef PG8_SB
#undef PG8_STAGE
#undef PG8_LDA
#undef PG8_LDB
#undef PG8_MMA
#undef PG8_WAIT_V
#undef PG8_WAIT_L
#undef PG8_BAR
#undef PG8_SCHED
}

template <int ACT> struct EpiB {
  static constexpr bool PERM = true;
  bf16* O; int ldc; int pm_wrap;
  __device__ __forceinline__ void operator()(const f32x4 (&acc)[2][2][4][2], const Unit& u, int wr, int wc, int fr, int fq) const {
    const int pm = u.pm >= pm_wrap ? u.pm - pm_wrap : u.pm;
    const int row0 = pm * BM + wr * 64 + fr, col0 = u.pn * BM + wc * 32 + 8 * fq;
#pragma unroll
    for (int ai = 0; ai < 2; ++ai)
#pragma unroll
      for (int m = 0; m < 4; ++m) {
        bf16* rowp = O + (size_t)(row0 + ai * HALF + m * 16) * ldc + col0;
#pragma unroll
        for (int bj = 0; bj < 2; ++bj) {
          f32x4 v0 = acc[ai][bj][m][0], v1 = acc[ai][bj][m][1];
          if (ACT == 1) {
            const f32x4 z = {0.f, 0.f, 0.f, 0.f};
            v0 = __builtin_elementwise_max(v0, z); v1 = __builtin_elementwise_max(v1, z);
            v0 = v0 * v0; v1 = v1 * v1;
          }
          if (ACT == 3) {
            const uint4 old = *(const uint4*)(rowp + bj * HALF);
            float f[8]; unpack8(old, f);
#pragma unroll
            for (int j = 0; j < 4; ++j) { v0[j] += f[j]; v1[j] += f[4 + j]; }
          }
          if (ACT == 2) {
            const uint4 old = *(const uint4*)(rowp + bj * HALF);
            float f[8]; unpack8(old, f);
#pragma unroll
            for (int j = 0; j < 4; ++j) { v0[j] = sigmoidf(v0[j]) * f[j]; v1[j] = sigmoidf(v1[j]) * f[4 + j]; }
          }
          u32x4 w; w.x = cvt_pk_bf16(v0[0], v0[1]); w.y = cvt_pk_bf16(v0[2], v0[3]); w.z = cvt_pk_bf16(v1[0], v1[1]); w.w = cvt_pk_bf16(v1[2], v1[3]);
          if (ACT == 1 || ACT == 2) {
            bf16* dstp = rowp + bj * HALF;
            asm volatile("global_store_dwordx4 %0, %1, off sc1\n\ts_nop 1" :: "v"(dstp), "v"(w) : "memory");
          } else
          *(u32x4*)(rowp + bj * HALF) = w;
        }
      }
  }
};
template <bool ACCUM> struct EpiF {
  static constexpr bool PERM = false;
  float* C; int ldc;
  __device__ __forceinline__ void operator()(const f32x4 (&acc)[2][2][4][2], const Unit& u, int wr, int wc, int fr, int fq) const {
    const int row0 = u.pm * BM + wr * 64 + fr, col0 = u.pn * BM + wc * 32 + 4 * fq;
#pragma unroll
    for (int ai = 0; ai < 2; ++ai)
#pragma unroll
      for (int m = 0; m < 4; ++m) {
        float* rowp = C + (size_t)(row0 + ai * HALF + m * 16) * ldc + col0;
#pragma unroll
        for (int bj = 0; bj < 2; ++bj)
#pragma unroll
          for (int n = 0; n < 2; ++n) {
            f32x4 v = acc[ai][bj][m][n];
            if (ACCUM) v += *(const f32x4*)(rowp + bj * HALF + n * 16);
            *(f32x4*)(rowp + bj * HALF + n * 16) = v;
          }
      }
  }
};
}

#define LDS3(l) ((PG8_LAS unsigned char*)(l))
__device__ __forceinline__ void phase_gemm_in(const P& p, int l, unsigned char* lds) {
  pg8::Gemm g{(const bf16*)(p.ws + OFF_U), (const bf16*)p.ws + (size_t)l * WBL + W_IN, 1024};
  pg8::StaticOrder S; S.init(MP, ZW, gridDim.x, blockIdx.x);
  pg8::EpiB<0> E{(bf16*)(p.ws + OFF_BIG), ZW, 1 << 20};
  pg8::gemm_phase(LDS3(lds), g, S, E);
}
__device__ __forceinline__ void phase_gemm_v(const P& p, int l, unsigned char* lds) {
  pg8::Gemm g{(const bf16*)(p.ws + OFF_YA), (const bf16*)p.ws + (size_t)l * WBL + W_PA, 512};
  pg8::PairUpOrder S{(int)gridDim.x, (int)blockIdx.x, 276 - (int)gridDim.x};
  pg8::EpiB<0> E{(bf16*)(p.ws + OFF_BIG), 2048, 69};
  pg8::gemm_phase(LDS3(lds), g, S, E);
}
__device__ __forceinline__ void phase_gemm_gate(const P& p, int l, unsigned char* lds) {
  pg8::Gemm g{(const bf16*)(p.ws + OFF_U), (const bf16*)p.ws + (size_t)l * WBL + W_IN + (size_t)3840 * 1024, 1024};
  pg8::UpOrder S; S.G = gridDim.x; S.c = blockIdx.x; S.h = 276 - (int)gridDim.x;
  S.ready = (unsigned*)(p.ws + OFF_CNT) + (size_t)(4 + l) * 69 * 64;
  pg8::EpiB<2> E{(bf16*)(p.ws + OFF_BIG), 2048, 1 << 20};
  pg8::gemm_phase(LDS3(lds), g, S, E);
}
__device__ __forceinline__ void phase_gemm_out(const P& p, int l, unsigned char* lds) {
  pg8::Gemm g{(const bf16*)(p.ws + OFF_BIG), (const bf16*)p.ws + (size_t)l * WBL + W_OUT2, 2048};
  pg8::DownOrder S; S.G = gridDim.x; S.c = blockIdx.x; S.h = 276 - (int)gridDim.x;
  S.ready = (const unsigned*)(p.ws + OFF_CNT) + (size_t)(4 + l) * 69 * 64; S.need = 64u;
  pg8::EpiB<0> E{(bf16*)(p.ws + OFF_T), 1024, 1 << 20};
  pg8::gemm_phase(LDS3(lds), g, S, E);
}
__device__ __forceinline__ void phase_gemm_up(const P& p, int l, int hf, unsigned char* lds) {
  pg8::Gemm g{(const bf16*)(p.ws + OFF_U), (const bf16*)p.ws + (size_t)l * WBL + W_UP + (size_t)hf * 2048 * 1024, 1024};
  pg8::UpOrder S; S.G = gridDim.x; S.c = blockIdx.x; S.h = 276 - (int)gridDim.x;
  S.ready = (unsigned*)(p.ws + OFF_CNT) + (size_t)(l * 2 + hf) * 69 * 64;
  pg8::EpiB<1> E{(bf16*)(p.ws + OFF_BIG), 2048, 1 << 20};
  pg8::gemm_phase(LDS3(lds), g, S, E);
}
__device__ __forceinline__ void phase_gemm_down(const P& p, int l, int hf, unsigned char* lds) {
  pg8::Gemm g{(const bf16*)(p.ws + OFF_BIG), (const bf16*)p.ws + (size_t)l * WBL + W_DN + (size_t)hf * 1024 * 2048, 2048};
  pg8::DownOrder S; S.G = gridDim.x; S.c = blockIdx.x; S.h = 276 - (int)gridDim.x;
  S.ready = (const unsigned*)(p.ws + OFF_CNT) + (size_t)(l * 2 + hf) * 69 * 64; S.need = 64u;
  pg8::EpiB<0> E{(bf16*)(p.ws + OFF_T) + (size_t)hf * MP * 1024, 1024, 1 << 20};
  pg8::gemm_phase(LDS3(lds), g, S, E);
}

constexpr int RTC = 32;
constexpr int RW_R = 0, RW_KR = 8192, RW_V = 16384, RW_DEC = 24576, RW_A = 32768, RW_G = 40960, RW_NKK = 49152,
              RW_KKA = 57344, RW_KP = 65536, RW_YR = 73728, RW_RK = 81920, RW_MU = 82048, RW_AW = 83840, RW_AA = 88448, RW_AG = 93056;

struct RwRegs { uint4 cur[4], prv[4]; };

__device__ __forceinline__ int rw_col(int seg, int h) {
  return seg < 8 ? h * 64 + seg * 8
       : seg < 16 ? 512 + h * 64 + (seg - 8) * 8
       : seg < 24 ? 1024 + h * 64 + (seg - 16) * 8
                  : 1536 + (seg - 24) * 8;
}
__device__ __forceinline__ void rw_issue(const P& p, int tid, int l, int type, int b, int h, int t0, int ntok, RwRegs& rg) {
  const bf16* Z = (const bf16*)(p.ws + OFF_BIG);
#pragma unroll
  for (int i = 0; i < 4; ++i) {
    int vec = tid + NTHR * i;
    rg.cur[i] = make_uint4(0, 0, 0, 0); rg.prv[i] = make_uint4(0, 0, 0, 0);
    if (vec < RTC * 56) {
      int tok = vec / 56, seg = vec % 56;
      if (tok < ntok) {
        int col = rw_col(seg, h);
        int t = t0 + tok;
        rg.cur[i] = *(const uint4*)(Z + (size_t)seq_row(type, b, t) * ZW + col);
        if (t > 0) rg.prv[i] = *(const uint4*)(Z + (size_t)seq_row(type, b, t - 1) * ZW + col);
        else if (type) {
          const float* s = p.in[3] + ((size_t)l * 128 + b) * 1792 + col;
          float f[8];
#pragma unroll
          for (int e = 0; e < 8; ++e) f[e] = s[e];
          rg.prv[i] = pack8(f);
        }
      }
    }
  }
}
__device__ __forceinline__ float fast_tanh(float x) { return 1.f - 2.f * __builtin_amdgcn_rcpf(1.f + __expf(2.f * x)); }

__device__ __forceinline__ void rwkv_item(const P& p, int l, int type, int b, int h, unsigned char* lds0) {
  const int tid = tidx(), lane = tid & 63, wave = tid >> 6;
  const int T = type ? 8 : 2064;
  const int nchunks = type ? 1 : 65;
  const int hc0 = l * 512 + h * 64;

  b8 bw[4];
  {
    const int c = h * 64 + (wave & 3) * 16 + (lane & 15);
    const int q = lane >> 4;
#pragma unroll
    for (int f = 0; f < 4; ++f) {
      const float* src; int kbase;
      if (wave < 4) { src = (f < 2 ? p.in[12] : p.in[14]) + (size_t)l * 64 * 512; kbase = (f & 1) * 32 + q * 8; }
      else { src = p.in[15] + (size_t)l * 128 * 512; kbase = f * 32 + q * 8; }
      float v[8];
#pragma unroll
      for (int e = 0; e < 8; ++e) v[e] = src[(size_t)(kbase + e) * 512 + c];
      uint4 pk = pack8(v);
      bw[f] = __builtin_bit_cast(b8, pk);
    }
  }
  const int cc = (wave & 3) * 16 + (lane & 15);
  const float w0c = p.in[11][hc0 + cc], a0c = p.in[13][hc0 + cc];
  const int c4 = (tid & 15) * 4;
  const float4 kkc = *(const float4*)(p.in[16] + hc0 + c4), kac = *(const float4*)(p.in[17] + hc0 + c4), rkc = *(const float4*)(p.in[18] + hc0 + c4);
  const float4 gnc = *(const float4*)(p.in[19] + hc0 + c4), gbc = *(const float4*)(p.in[20] + hc0 + c4);
  {
    float* MU = (float*)(lds0 + RW_MU);
    if (tid < 448) MU[tid] = p.in[10][l * 1792 + rw_col(tid >> 3, h) + (tid & 7)];
  }
  const int rp = lane >> 4, kq = lane & 15;
  const int ra = wave * 8 + rp * 2, k0 = kq * 4;
  float Sa[4], Sb[4];
  if (type) {
    const float* s0 = p.in[2] + (((size_t)l * 128 + b) * 8 + h) * 4096;
    float4 a = *(const float4*)(s0 + ra * 64 + k0), bq = *(const float4*)(s0 + (ra + 1) * 64 + k0);
    Sa[0] = a.x; Sa[1] = a.y; Sa[2] = a.z; Sa[3] = a.w; Sb[0] = bq.x; Sb[1] = bq.y; Sb[2] = bq.z; Sb[3] = bq.w;
  } else {
#pragma unroll
    for (int j = 0; j < 4; ++j) { Sa[j] = 0.f; Sb[j] = 0.f; }
  }
  RwRegs rg;
  rw_issue(p, tid, l, type, b, h, 0, T < RTC ? T : RTC, rg);
  __syncthreads();

#pragma unroll 1
  for (int c = 0; c < nchunks; ++c) {
    int opq = 0;
    asm volatile("" : "+v"(opq));
    unsigned char* lds = lds0 + opq;
    float* R = (float*)(lds + RW_R); float* KR = (float*)(lds + RW_KR); float* V = (float*)(lds + RW_V);
    float* DEC = (float*)(lds + RW_DEC); float* AA = (float*)(lds + RW_A); float* GG = (float*)(lds + RW_G);
    float* NKK = (float*)(lds + RW_NKK); float* KKA = (float*)(lds + RW_KKA); float* KP = (float*)(lds + RW_KP);
    float* YR = (float*)(lds + RW_YR); float* RK = (float*)(lds + RW_RK); const float* MU = (const float*)(lds + RW_MU);
    bf16* AW = (bf16*)(lds + RW_AW); bf16* AAL = (bf16*)(lds + RW_AA); bf16* AG = (bf16*)(lds + RW_AG);
    const int t0 = c * RTC;
    const int ntok = (T - t0) < RTC ? (T - t0) : RTC;
#pragma unroll
    for (int i = 0; i < 4; ++i) {
      int vec = tid + NTHR * i;
      if (vec < RTC * 56) {
        int tok = vec / 56, seg = vec % 56;
        float zc[8], zp[8], zs[8];
        unpack8(rg.cur[i], zc); unpack8(rg.prv[i], zp);
        float4 m0 = *(const float4*)(MU + seg * 8), m1 = *(const float4*)(MU + seg * 8 + 4);
        float mm[8] = {m0.x, m0.y, m0.z, m0.w, m1.x, m1.y, m1.z, m1.w};
#pragma unroll
        for (int e = 0; e < 8; ++e) zs[e] = zc[e] + (zp[e] - zc[e]) * mm[e];
        if (seg < 24) {
          float* dst = (seg < 8 ? R : seg < 16 ? KR : V) + tok * 64 + (seg & 7) * 8;
          *(float4*)dst = make_float4(zs[0], zs[1], zs[2], zs[3]);
          *(float4*)(dst + 4) = make_float4(zs[4], zs[5], zs[6], zs[7]);
        } else if (seg < 32) {
#pragma unroll
          for (int e = 0; e < 8; ++e) zs[e] = fast_tanh(zs[e]);
          *(uint4*)(AW + tok * 72 + (seg - 24) * 8) = pack8(zs);
        } else if (seg < 40) {
          *(uint4*)(AAL + tok * 72 + (seg - 32) * 8) = pack8(zs);
        } else {
#pragma unroll
          for (int e = 0; e < 8; ++e) zs[e] = sigmoidf(zs[e]);
          *(uint4*)(AG + tok * 136 + (seg - 40) * 8) = pack8(zs);
        }
      }
    }
    __syncthreads();
    {
      const int tokr = lane & 15, q = lane >> 4;
#pragma unroll
      for (int mt = 0; mt < 2; ++mt) {
        const int tr = mt * 16 + tokr;
        if (wave < 4) {
          f32x4 aw = {0, 0, 0, 0}, a2 = {0, 0, 0, 0};
#pragma unroll
          for (int ks = 0; ks < 2; ++ks) {
            b8 x = *(const b8*)(AW + tr * 72 + ks * 32 + q * 8);
            aw = __builtin_amdgcn_mfma_f32_16x16x32_bf16(x, bw[ks], aw, 0, 0, 0);
            b8 y = *(const b8*)(AAL + tr * 72 + ks * 32 + q * 8);
            a2 = __builtin_amdgcn_mfma_f32_16x16x32_bf16(y, bw[2 + ks], a2, 0, 0, 0);
          }
#pragma unroll
          for (int j = 0; j < 4; ++j) {
            int tok = mt * 16 + q * 4 + j;
            float xw = -(w0c + aw[j]);
            float w = -(fmaxf(xw, 0.f) + __logf(1.f + __expf(-fabsf(xw)))) - 0.5f;
            DEC[tok * 64 + cc] = __expf(-__expf(w));
            AA[tok * 64 + cc] = sigmoidf(a0c + a2[j]);
          }
        } else {
          f32x4 ag = {0, 0, 0, 0};
#pragma unroll
          for (int ks = 0; ks < 4; ++ks) {
            b8 x = *(const b8*)(AG + tr * 136 + ks * 32 + q * 8);
            ag = __builtin_amdgcn_mfma_f32_16x16x32_bf16(x, bw[ks], ag, 0, 0, 0);
          }
#pragma unroll
          for (int j = 0; j < 4; ++j) GG[(mt * 16 + q * 4 + j) * 64 + cc] = ag[j];
        }
      }
    }
    __syncthreads();
    {
      const int tok = tid >> 4;
      const float4 kr = *(const float4*)(KR + tok * 64 + c4);
      const float4 av = *(const float4*)(AA + tok * 64 + c4);
      const float4 rv = *(const float4*)(R + tok * 64 + c4);
      float4 kk = make_float4(kr.x * kkc.x, kr.y * kkc.y, kr.z * kkc.z, kr.w * kkc.w);
      float ss = sum16(kk.x * kk.x + kk.y * kk.y + kk.z * kk.z + kk.w * kk.w);
      float inv = rsqrtf(fmaxf(ss, 1e-24f));
      kk.x *= inv; kk.y *= inv; kk.z *= inv; kk.w *= inv;
      float4 kp = make_float4(kr.x * (1.f + (av.x - 1.f) * kac.x), kr.y * (1.f + (av.y - 1.f) * kac.y),
                              kr.z * (1.f + (av.z - 1.f) * kac.z), kr.w * (1.f + (av.w - 1.f) * kac.w));
      *(float4*)(NKK + tok * 64 + c4) = make_float4(-kk.x, -kk.y, -kk.z, -kk.w);
      *(float4*)(KKA + tok * 64 + c4) = make_float4(kk.x * av.x, kk.y * av.y, kk.z * av.z, kk.w * av.w);
      *(float4*)(KP + tok * 64 + c4) = kp;
      float rk = sum16(rv.x * kp.x * rkc.x + rv.y * kp.y * rkc.y + rv.z * kp.z * rkc.z + rv.w * kp.w * rkc.w);
      if ((tid & 15) == 0) RK[tok] = rk;
    }
    __syncthreads();
    if (c + 1 < nchunks) rw_issue(p, tid, l, type, b, h, t0 + RTC, (T - t0 - RTC) < RTC ? (T - t0 - RTC) : RTC, rg);
    {
      float4 nk = *(const float4*)(NKK + k0), ka = *(const float4*)(KKA + k0), kp = *(const float4*)(KP + k0);
      float4 dc = *(const float4*)(DEC + k0), rr = *(const float4*)(R + k0);
      float2 vv = *(const float2*)(V + ra);
#pragma unroll 1
      for (int t = 0; t < ntok; ++t) {
        const int tn = (t + 1 < RTC ? t + 1 : t) * 64;
        const float4 nk2 = *(const float4*)(NKK + tn + k0), ka2 = *(const float4*)(KKA + tn + k0), kp2 = *(const float4*)(KP + tn + k0);
        const float4 dc2 = *(const float4*)(DEC + tn + k0), rr2 = *(const float4*)(R + tn + k0);
        const float2 vv2 = *(const float2*)(V + tn + ra);
        float sa = Sa[0] * nk.x + Sa[1] * nk.y + Sa[2] * nk.z + Sa[3] * nk.w;
        float sb = Sb[0] * nk.x + Sb[1] * nk.y + Sb[2] * nk.z + Sb[3] * nk.w;
        sa = sum16(sa); sb = sum16(sb);
        Sa[0] = Sa[0] * dc.x + (sa * ka.x + vv.x * kp.x);
        Sa[1] = Sa[1] * dc.y + (sa * ka.y + vv.x * kp.y);
        Sa[2] = Sa[2] * dc.z + (sa * ka.z + vv.x * kp.z);
        Sa[3] = Sa[3] * dc.w + (sa * ka.w + vv.x * kp.w);
        Sb[0] = Sb[0] * dc.x + (sb * ka.x + vv.y * kp.x);
        Sb[1] = Sb[1] * dc.y + (sb * ka.y + vv.y * kp.y);
        Sb[2] = Sb[2] * dc.z + (sb * ka.z + vv.y * kp.z);
        Sb[3] = Sb[3] * dc.w + (sb * ka.w + vv.y * kp.w);
        float ya = Sa[0] * rr.x + Sa[1] * rr.y + Sa[2] * rr.z + Sa[3] * rr.w;
        float yb = Sb[0] * rr.x + Sb[1] * rr.y + Sb[2] * rr.z + Sb[3] * rr.w;
        ya = sum16(ya); yb = sum16(yb);
        if (kq == 0) *(float2*)(YR + t * 64 + ra) = make_float2(ya, yb);
        nk = nk2; ka = ka2; kp = kp2; dc = dc2; rr = rr2; vv = vv2;
      }
    }
    __syncthreads();
    {
      const int tok = tid >> 4;
      const float4 y = *(const float4*)(YR + tok * 64 + c4);
      const float4 vv = *(const float4*)(V + tok * 64 + c4);
      const float4 gg = *(const float4*)(GG + tok * 64 + c4);
      float mean = sum16(y.x + y.y + y.z + y.w) * (1.f / 64.f);
      float d0 = y.x - mean, d1 = y.y - mean, d2 = y.z - mean, d3 = y.w - mean;
      float rs = rsqrtf(sum16(d0 * d0 + d1 * d1 + d2 * d2 + d3 * d3) * (1.f / 64.f) + 64e-5f);
      float rk = RK[tok];
      float o0 = (d0 * rs * gnc.x + gbc.x + rk * vv.x) * gg.x;
      float o1 = (d1 * rs * gnc.y + gbc.y + rk * vv.y) * gg.y;
      float o2 = (d2 * rs * gnc.z + gbc.z + rk * vv.z) * gg.z;
      float o3 = (d3 * rs * gnc.w + gbc.w + rk * vv.w) * gg.w;
      if (tok < ntok) {
        bf16* ya = (bf16*)(p.ws + OFF_YA) + (size_t)seq_row(type, b, t0 + tok) * 512 + h * 64 + c4;
        uint2 pk; pk.x = pack2(o0, o1); pk.y = pack2(o2, o3);
        *(uint2*)ya = pk;
      }
    }
    __syncthreads();
  }
  {
    float* so = type ? p.out + O_SS + (((size_t)l * 128 + b) * 8 + h) * 4096 : p.out + O_PS + (((size_t)l * 8 + b) * 8 + h) * 4096;
    *(float4*)(so + ra * 64 + k0) = make_float4(Sa[0], Sa[1], Sa[2], Sa[3]);
    *(float4*)(so + (ra + 1) * 64 + k0) = make_float4(Sb[0], Sb[1], Sb[2], Sb[3]);
  }
}

__device__ __forceinline__ unsigned ld_flag(const unsigned* f) { return __hip_atomic_load(f, __ATOMIC_RELAXED, __HIP_MEMORY_SCOPE_AGENT); }
__device__ __forceinline__ void wait_flag(const unsigned* f, unsigned need) {
  unsigned polls = 0;
  while (ld_flag(f) < need) { __builtin_amdgcn_s_sleep(4); if (++polls > (1u << 22)) break; }
}

__device__ __forceinline__ void rwkv_producer(const P& p, int l, int b, int h, unsigned char* lds0) {
  const int tid = tidx(), lane = tid & 63, wave = tid >> 6;
  const int T = 2064, nchunks = 65, type = 0;
  const int hc0 = l * 512 + h * 64;
  int item_opq = 0; asm volatile("" : "+s"(item_opq));
  const int item = b * 8 + h + item_opq;
  unsigned* flags = (unsigned*)(p.ws + OFF_FLAG) + ((size_t)l * 64 + item) * 64;
  float* ring = (float*)(p.ws + OFF_RING) + (size_t)item * RING_NSLOT * RING_SLOT_F;
  b8 bw[4];
  {
    const int c = h * 64 + (wave & 3) * 16 + (lane & 15);
    const int q = lane >> 4;
#pragma unroll
    for (int f = 0; f < 4; ++f) {
      const float* src; int kbase;
      if (wave < 4) { src = (f < 2 ? p.in[12] : p.in[14]) + (size_t)l * 64 * 512; kbase = (f & 1) * 32 + q * 8; }
      else { src = p.in[15] + (size_t)l * 128 * 512; kbase = f * 32 + q * 8; }
      float v[8];
#pragma unroll
      for (int e = 0; e < 8; ++e) v[e] = src[(size_t)(kbase + e) * 512 + c];
      uint4 pk = pack8(v);
      bw[f] = __builtin_bit_cast(b8, pk);
    }
  }
  const int cc = (wave & 3) * 16 + (lane & 15);
  const float w0c = p.in[11][hc0 + cc], a0c = p.in[13][hc0 + cc];
  const int c4 = (tid & 15) * 4;
  const float4 kkc = *(const float4*)(p.in[16] + hc0 + c4), kac = *(const float4*)(p.in[17] + hc0 + c4), rkc = *(const float4*)(p.in[18] + hc0 + c4);
  {
    float* MU = (float*)(lds0 + RW_MU);
    if (tid < 448) MU[tid] = p.in[10][l * 1792 + rw_col(tid >> 3, h) + (tid & 7)];
  }
  __syncthreads();
  unsigned cf_seen = 0u;
  RwRegs rg;
  rw_issue(p, tid, l, type, b, h, 0, RTC, rg);
#pragma unroll 1
  for (int c = 0; c < nchunks; ++c) {
    int opq = 0;
    asm volatile("" : "+v"(opq));
    unsigned char* lds = lds0 + opq;
    float* R = (float*)(lds + RW_R); float* KR = (float*)(lds + RW_KR); float* V = (float*)(lds + RW_V);
    float* DEC = (float*)(lds + RW_DEC); float* AA = (float*)(lds + RW_A); float* GG = (float*)(lds + RW_G);
    float* NKK = (float*)(lds + RW_NKK); float* KKA = (float*)(lds + RW_KKA); float* KP = (float*)(lds + RW_KP);
    float* RK = (float*)(lds + RW_RK); const float* MU = (const float*)(lds + RW_MU);
    bf16* AW = (bf16*)(lds + RW_AW); bf16* AAL = (bf16*)(lds + RW_AA); bf16* AG = (bf16*)(lds + RW_AG);
    const int t0 = c * RTC;
    if (c >= RING_NSLOT) { if (tid == 0 && cf_seen < (unsigned)(c - RING_NSLOT + 1)) wait_flag(flags + 32, (unsigned)(c - RING_NSLOT + 1)); }
#pragma unroll
    for (int i = 0; i < 4; ++i) {
      int vec = tid + NTHR * i;
      if (vec < RTC * 56) {
        int tok = vec / 56, seg = vec % 56;
        float zc[8], zp[8], zs[8];
        unpack8(rg.cur[i], zc); unpack8(rg.prv[i], zp);
        float4 m0 = *(const float4*)(MU + seg * 8), m1 = *(const float4*)(MU + seg * 8 + 4);
        float mm[8] = {m0.x, m0.y, m0.z, m0.w, m1.x, m1.y, m1.z, m1.w};
#pragma unroll
        for (int e = 0; e < 8; ++e) zs[e] = zc[e] + (zp[e] - zc[e]) * mm[e];
        if (seg < 24) {
          float* dst = (seg < 8 ? R : seg < 16 ? KR : V) + tok * 64 + (seg & 7) * 8;
          *(float4*)dst = make_float4(zs[0], zs[1], zs[2], zs[3]);
          *(float4*)(dst + 4) = make_float4(zs[4], zs[5], zs[6], zs[7]);
        } else if (seg < 32) {
#pragma unroll
          for (int e = 0; e < 8; ++e) zs[e] = fast_tanh(zs[e]);
          *(uint4*)(AW + tok * 72 + (seg - 24) * 8) = pack8(zs);
        } else if (seg < 40) {
          *(uint4*)(AAL + tok * 72 + (seg - 32) * 8) = pack8(zs);
        } else {
#pragma unroll
          for (int e = 0; e < 8; ++e) zs[e] = sigmoidf(zs[e]);
          *(uint4*)(AG + tok * 136 + (seg - 40) * 8) = pack8(zs);
        }
      }
    }
    __syncthreads();
    if (c + 1 < nchunks) rw_issue(p, tid, l, type, b, h, t0 + RTC, (T - t0 - RTC) < RTC ? (T - t0 - RTC) : RTC, rg);
    {
      const int tokr = lane & 15, q = lane >> 4;
#pragma unroll
      for (int mt = 0; mt < 2; ++mt) {
        const int tr = mt * 16 + tokr;
        if (wave < 4) {
          f32x4 aw = {0, 0, 0, 0}, a2 = {0, 0, 0, 0};
#pragma unroll
          for (int ks = 0; ks < 2; ++ks) {
            b8 x = *(const b8*)(AW + tr * 72 + ks * 32 + q * 8);
            aw = __builtin_amdgcn_mfma_f32_16x16x32_bf16(x, bw[ks], aw, 0, 0, 0);
            b8 y = *(const b8*)(AAL + tr * 72 + ks * 32 + q * 8);
            a2 = __builtin_amdgcn_mfma_f32_16x16x32_bf16(y, bw[2 + ks], a2, 0, 0, 0);
          }
#pragma unroll
          for (int j = 0; j < 4; ++j) {
            int tok = mt * 16 + q * 4 + j;
            float xw = -(w0c + aw[j]);
            float w = -(fmaxf(xw, 0.f) + __logf(1.f + __expf(-fabsf(xw)))) - 0.5f;
            DEC[tok * 64 + cc] = __expf(-__expf(w));
            AA[tok * 64 + cc] = sigmoidf(a0c + a2[j]);
          }
        } else {
          f32x4 ag = {0, 0, 0, 0};
#pragma unroll
          for (int ks = 0; ks < 4; ++ks) {
            b8 x = *(const b8*)(AG + tr * 136 + ks * 32 + q * 8);
            ag = __builtin_amdgcn_mfma_f32_16x16x32_bf16(x, bw[ks], ag, 0, 0, 0);
          }
#pragma unroll
          for (int j = 0; j < 4; ++j) GG[(mt * 16 + q * 4 + j) * 64 + cc] = ag[j];
        }
      }
    }
    __syncthreads();
    {
      const int tok = tid >> 4;
      const float4 kr = *(const float4*)(KR + tok * 64 + c4);
      const float4 av = *(const float4*)(AA + tok * 64 + c4);
      const float4 rv = *(const float4*)(R + tok * 64 + c4);
      float4 kk = make_float4(kr.x * kkc.x, kr.y * kkc.y, kr.z * kkc.z, kr.w * kkc.w);
      float ss = sum16(kk.x * kk.x + kk.y * kk.y + kk.z * kk.z + kk.w * kk.w);
      float inv = rsqrtf(fmaxf(ss, 1e-24f));
      kk.x *= inv; kk.y *= inv; kk.z *= inv; kk.w *= inv;
      float4 kp = make_float4(kr.x * (1.f + (av.x - 1.f) * kac.x), kr.y * (1.f + (av.y - 1.f) * kac.y),
                              kr.z * (1.f + (av.z - 1.f) * kac.z), kr.w * (1.f + (av.w - 1.f) * kac.w));
      *(float4*)(NKK + tok * 64 + c4) = make_float4(-kk.x, -kk.y, -kk.z, -kk.w);
      *(float4*)(KKA + tok * 64 + c4) = make_float4(kk.x * av.x, kk.y * av.y, kk.z * av.z, kk.w * av.w);
      *(float4*)(KP + tok * 64 + c4) = kp;
      float rk = sum16(rv.x * kp.x * rkc.x + rv.y * kp.y * rkc.y + rv.z * kp.z * rkc.z + rv.w * kp.w * rkc.w);
      if ((tid & 15) == 0) RK[tok] = rk;
    }
    __syncthreads();
    {
      float* slot = ring + (size_t)(c % RING_NSLOT) * RING_SLOT_F;
#define ST_SC1_F4(dst_, val_) do { float* d_ = (dst_); const float4 t_ = (val_); f32x4 v_ = {t_.x, t_.y, t_.z, t_.w}; asm volatile("global_store_dwordx4 %0, %1, off sc1\n\ts_nop 1" :: "v"(d_), "v"(v_) : "memory"); } while (0)
      ST_SC1_F4(slot + 0 * 2048 + tid * 4, *(const float4*)(R + tid * 4));
      ST_SC1_F4(slot + 1 * 2048 + tid * 4, *(const float4*)(V + tid * 4));
      ST_SC1_F4(slot + 2 * 2048 + tid * 4, *(const float4*)(DEC + tid * 4));
      ST_SC1_F4(slot + 3 * 2048 + tid * 4, *(const float4*)(GG + tid * 4));
      ST_SC1_F4(slot + 4 * 2048 + tid * 4, *(const float4*)(NKK + tid * 4));
      ST_SC1_F4(slot + 5 * 2048 + tid * 4, *(const float4*)(KKA + tid * 4));
      ST_SC1_F4(slot + 6 * 2048 + tid * 4, *(const float4*)(KP + tid * 4));
#undef ST_SC1_F4
      if (tid < 32) { float* d_ = slot + 7 * 2048 + tid; float v_ = RK[tid]; asm volatile("global_store_dword %0, %1, off sc1\n\ts_nop 1" :: "v"(d_), "v"(v_) : "memory"); }
      asm volatile("s_waitcnt vmcnt(0)" ::: "memory");
      __syncthreads();
      if (tid == 0) { __hip_atomic_store(flags, (unsigned)(c + 1), __ATOMIC_RELAXED, __HIP_MEMORY_SCOPE_AGENT); cf_seen = ld_flag(flags + 32); }
    }
  }
  __syncthreads();
}

__device__ __forceinline__ float4 ld_sc1_f4(__amdgpu_buffer_rsrc_t r, unsigned off) {
  pg8::u32x4 v = __builtin_amdgcn_raw_buffer_load_b128(r, off, 0, 16);
  return make_float4(__uint_as_float(v.x), __uint_as_float(v.y), __uint_as_float(v.z), __uint_as_float(v.w));
}
#define CONS_LOAD(slotidx_)                                                                \
  do { const unsigned so_ = (unsigned)(slotidx_) * (unsigned)(RING_SLOT_F * 4) + (unsigned)tid * 16u; \
    cr0 = ld_sc1_f4(rsrc, so_ + 0 * 8192u); cr1 = ld_sc1_f4(rsrc, so_ + 1 * 8192u);       \
    cr2 = ld_sc1_f4(rsrc, so_ + 2 * 8192u); cr3 = ld_sc1_f4(rsrc, so_ + 3 * 8192u);       \
    cr4 = ld_sc1_f4(rsrc, so_ + 4 * 8192u); cr5 = ld_sc1_f4(rsrc, so_ + 5 * 8192u);       \
    cr6 = ld_sc1_f4(rsrc, so_ + 6 * 8192u);                                                \
    crk = __uint_as_float(__builtin_amdgcn_raw_buffer_load_b32(rsrc, (unsigned)(slotidx_) * (unsigned)(RING_SLOT_F * 4) + 7u * 8192u + (unsigned)(tid & 31) * 4u, 0, 16)); } while (0)

__device__ __forceinline__ void rwkv_consumer(const P& p, int l, int b, int h, unsigned char* lds0) {
  const int tid = tidx(), lane = tid & 63, wave = tid >> 6;
  const int T = 2064, nchunks = 65;
  const int hc0 = l * 512 + h * 64;
  int item_opq = 0; asm volatile("" : "+s"(item_opq));
  const int item = b * 8 + h + item_opq;
  unsigned* flags = (unsigned*)(p.ws + OFF_FLAG) + ((size_t)l * 64 + item) * 64;
  const float* ring = (const float*)(p.ws + OFF_RING) + (size_t)item * RING_NSLOT * RING_SLOT_F;
  const int c4 = (tid & 15) * 4;
  const float4 gnc = *(const float4*)(p.in[19] + hc0 + c4), gbc = *(const float4*)(p.in[20] + hc0 + c4);
  const int rp = lane >> 4, kq = lane & 15;
  const int ra = wave * 8 + rp * 2, k0 = kq * 4;
  float Sa[4], Sb[4];
#pragma unroll
  for (int j = 0; j < 4; ++j) { Sa[j] = 0.f; Sb[j] = 0.f; }
  float4 cr0, cr1, cr2, cr3, cr4, cr5, cr6; float crk;
  const __amdgpu_buffer_rsrc_t rsrc = __builtin_amdgcn_make_buffer_rsrc((void*)ring, (short)0, RING_NSLOT * RING_SLOT_F * 4, 0x00020000);
  if (tid == 0) wait_flag(flags, 1u);
  __syncthreads();
  CONS_LOAD(0);
  unsigned fl_seen = 0u;
  if (tid == 0) fl_seen = ld_flag(flags);
#pragma unroll 1
  for (int c = 0; c < nchunks; ++c) {
    int opq = 0;
    asm volatile("" : "+v"(opq));
    unsigned char* lds = lds0 + opq;
    float* R = (float*)(lds + RW_R); float* V = (float*)(lds + RW_V);
    float* DEC = (float*)(lds + RW_DEC); float* GG = (float*)(lds + RW_G);
    float* NKK = (float*)(lds + RW_NKK); float* KKA = (float*)(lds + RW_KKA); float* KP = (float*)(lds + RW_KP);
    float* YR = (float*)(lds + RW_YR); float* RK = (float*)(lds + RW_RK);
    const int t0 = c * RTC;
    const int ntok = (T - t0) < RTC ? (T - t0) : RTC;
    *(float4*)(R + tid * 4) = cr0; *(float4*)(V + tid * 4) = cr1; *(float4*)(DEC + tid * 4) = cr2;
    *(float4*)(GG + tid * 4) = cr3; *(float4*)(NKK + tid * 4) = cr4; *(float4*)(KKA + tid * 4) = cr5;
    *(float4*)(KP + tid * 4) = cr6;
    if (tid < 32) RK[tid] = crk;
    if (tid == 0 && c + 1 < nchunks && fl_seen < (unsigned)(c + 2)) wait_flag(flags, (unsigned)(c + 2));
    __syncthreads();
    if (tid == 0) __hip_atomic_store(flags + 32, (unsigned)(c + 1), __ATOMIC_RELAXED, __HIP_MEMORY_SCOPE_AGENT);
    if (c + 1 < nchunks) CONS_LOAD((c + 1) % RING_NSLOT);
    if (tid == 0) fl_seen = ld_flag(flags);
    {
      const bool odd = (lane & 1) != 0, hi2 = (lane & 2) != 0;
      float sa, sb;
      {
        const float4 nk = *(const float4*)(NKK + k0);
        sa = sum16(Sa[0] * nk.x + Sa[1] * nk.y + Sa[2] * nk.z + Sa[3] * nk.w);
        sb = sum16(Sb[0] * nk.x + Sb[1] * nk.y + Sb[2] * nk.z + Sb[3] * nk.w);
      }
#define RW_LOAD(KA, KP_, DC, RR, NK, VV, tt)                                                         \
      { const int t_ = (tt) < ntok ? (tt) : ntok - 1; const int tn_ = (t_ + 1 < ntok ? t_ + 1 : t_) * 64; \
        KA = *(const float4*)(KKA + t_ * 64 + k0); KP_ = *(const float4*)(KP + t_ * 64 + k0);            \
        DC = *(const float4*)(DEC + t_ * 64 + k0); RR = *(const float4*)(R + t_ * 64 + k0);             \
        NK = *(const float4*)(NKK + tn_ + k0); VV = *(const float2*)(V + t_ * 64 + ra); }
#define RW_STEP(KA, KP_, DC, RR, NK, VV, tt)                                                         \
      { Sa[0] = Sa[0] * DC.x + (sa * KA.x + VV.x * KP_.x); Sa[1] = Sa[1] * DC.y + (sa * KA.y + VV.x * KP_.y); \
        Sa[2] = Sa[2] * DC.z + (sa * KA.z + VV.x * KP_.z); Sa[3] = Sa[3] * DC.w + (sa * KA.w + VV.x * KP_.w); \
        Sb[0] = Sb[0] * DC.x + (sb * KA.x + VV.y * KP_.x); Sb[1] = Sb[1] * DC.y + (sb * KA.y + VV.y * KP_.y); \
        Sb[2] = Sb[2] * DC.z + (sb * KA.z + VV.y * KP_.z); Sb[3] = Sb[3] * DC.w + (sb * KA.w + VV.y * KP_.w); \
        const float pA = Sa[0] * NK.x + Sa[1] * NK.y + Sa[2] * NK.z + Sa[3] * NK.w;                  \
        const float pB = Sb[0] * NK.x + Sb[1] * NK.y + Sb[2] * NK.z + Sb[3] * NK.w;                  \
        const float pC = Sa[0] * RR.x + Sa[1] * RR.y + Sa[2] * RR.z + Sa[3] * RR.w;                  \
        const float pD = Sb[0] * RR.x + Sb[1] * RR.y + Sb[2] * RR.z + Sb[3] * RR.w;                  \
        const float X = (odd ? pB : pA) + dppf<0xB1>(odd ? pA : pB);                                 \
        const float Y = (odd ? pD : pC) + dppf<0xB1>(odd ? pC : pD);                                 \
        float Z = (hi2 ? Y : X) + dppf<0x4E>(hi2 ? X : Y);                                           \
        Z += dppf<0x124>(Z); Z += dppf<0x128>(Z);                                                    \
        sa = dppf<0x00>(Z); sb = dppf<0x55>(Z);                                                      \
        if ((kq & 14) == 2) YR[(tt) * 64 + ra + (kq & 1)] = Z; }
      float4 ka0, kp0, dc0, rr0, nk0, ka1, kp1, dc1, rr1, nk1; float2 vv0, vv1;
      RW_LOAD(ka0, kp0, dc0, rr0, nk0, vv0, 0)
#pragma unroll 1
      for (int t = 0; t < ntok; t += 8) {
        RW_LOAD(ka1, kp1, dc1, rr1, nk1, vv1, t + 1)
        __builtin_amdgcn_sched_barrier(0);
        RW_STEP(ka0, kp0, dc0, rr0, nk0, vv0, t + 0)
        __builtin_amdgcn_sched_barrier(0);
        RW_LOAD(ka0, kp0, dc0, rr0, nk0, vv0, t + 2)
        __builtin_amdgcn_sched_barrier(0);
        RW_STEP(ka1, kp1, dc1, rr1, nk1, vv1, t + 1)
        __builtin_amdgcn_sched_barrier(0);
        RW_LOAD(ka1, kp1, dc1, rr1, nk1, vv1, t + 3)
        __builtin_amdgcn_sched_barrier(0);
        RW_STEP(ka0, kp0, dc0, rr0, nk0, vv0, t + 2)
        __builtin_amdgcn_sched_barrier(0);
        RW_LOAD(ka0, kp0, dc0, rr0, nk0, vv0, t + 4)
        __builtin_amdgcn_sched_barrier(0);
        RW_STEP(ka1, kp1, dc1, rr1, nk1, vv1, t + 3)
        __builtin_amdgcn_sched_barrier(0);
        RW_LOAD(ka1, kp1, dc1, rr1, nk1, vv1, t + 5)
        __builtin_amdgcn_sched_barrier(0);
        RW_STEP(ka0, kp0, dc0, rr0, nk0, vv0, t + 4)
        __builtin_amdgcn_sched_barrier(0);
        RW_LOAD(ka0, kp0, dc0, rr0, nk0, vv0, t + 6)
        __builtin_amdgcn_sched_barrier(0);
        RW_STEP(ka1, kp1, dc1, rr1, nk1, vv1, t + 5)
        __builtin_amdgcn_sched_barrier(0);
        RW_LOAD(ka1, kp1, dc1, rr1, nk1, vv1, t + 7)
        __builtin_amdgcn_sched_barrier(0);
        RW_STEP(ka0, kp0, dc0, rr0, nk0, vv0, t + 6)
        __builtin_amdgcn_sched_barrier(0);
        RW_LOAD(ka0, kp0, dc0, rr0, nk0, vv0, t + 8)
        __builtin_amdgcn_sched_barrier(0);
        RW_STEP(ka1, kp1, dc1, rr1, nk1, vv1, t + 7)
        __builtin_amdgcn_sched_barrier(0);
      }
#undef RW_LOAD
#undef RW_STEP
    }
    __syncthreads();
    {
      const int tok = tid >> 4;
      const float4 y = *(const float4*)(YR + tok * 64 + c4);
      const float4 vv = *(const float4*)(V + tok * 64 + c4);
      const float4 gg = *(const float4*)(GG + tok * 64 + c4);
      float mean = sum16(y.x + y.y + y.z + y.w) * (1.f / 64.f);
      float d0 = y.x - mean, d1 = y.y - mean, d2 = y.z - mean, d3 = y.w - mean;
      float rs = rsqrtf(sum16(d0 * d0 + d1 * d1 + d2 * d2 + d3 * d3) * (1.f / 64.f) + 64e-5f);
      float rk = RK[tok];
      float o0 = (d0 * rs * gnc.x + gbc.x + rk * vv.x) * gg.x;
      float o1 = (d1 * rs * gnc.y + gbc.y + rk * vv.y) * gg.y;
      float o2 = (d2 * rs * gnc.z + gbc.z + rk * vv.z) * gg.z;
      float o3 = (d3 * rs * gnc.w + gbc.w + rk * vv.w) * gg.w;
      if (tok < ntok) {
        bf16* ya = (bf16*)(p.ws + OFF_YA) + (size_t)seq_row(0, b, t0 + tok) * 512 + h * 64 + c4;
        uint2 pk; pk.x = pack2(o0, o1); pk.y = pack2(o2, o3);
        *(uint2*)ya = pk;
      }
    }
    __syncthreads();
  }
  {
    float* so = p.out + O_PS + (((size_t)l * 8 + b) * 8 + h) * 4096;
    *(float4*)(so + ra * 64 + k0) = make_float4(Sa[0], Sa[1], Sa[2], Sa[3]);
    *(float4*)(so + (ra + 1) * 64 + k0) = make_float4(Sb[0], Sb[1], Sb[2], Sb[3]);
  }
}

constexpr int ML_Q = 0, ML_K = 17408, ML_K2 = 34816, ML_V = 52224, ML_CB = 69632, ML_AQ = 104448, ML_HS = 113664,
              ML_SG = 149056, ML_SM = 149312, ML_SSC = 149568, ML_SEMT = 149824, ML_SWC = 150080, ML_SNQ = 150336,
              ML_SRD = 150592, ML_SN = 150848, ML_MISC = 151360, ML_CW = 151424, ML_GN = 156544;

__device__ __forceinline__ b8 gather_frag(const bf16* base  ) {
  unsigned w[4];
#pragma unroll
  for (int e = 0; e < 4; ++e) w[e] = (unsigned)base[(2 * e) * 136] | ((unsigned)base[(2 * e + 1) * 136] << 16);
  uint4 pk = make_uint4(w[0], w[1], w[2], w[3]);
  return __builtin_bit_cast(b8, pk);
}

#define ML_PTRS(base)                                                                                                   \
  bf16* Qs = (bf16*)((base) + ML_Q); bf16* Ks = (bf16*)((base) + ML_K); bf16* K2s = (bf16*)((base) + ML_K2);             \
  bf16* Vs = (bf16*)((base) + ML_V); bf16* Cb = (bf16*)((base) + ML_CB); bf16* AQ = (bf16*)((base) + ML_AQ);             \
  float* Hs = (float*)((base) + ML_HS); bf16* RAW = (bf16*)((base) + ML_HS); float* sG = (float*)((base) + ML_SG);       \
  float* sM = (float*)((base) + ML_SM);                                                                                  \
  float* sSC = (float*)((base) + ML_SSC); float* sEMT = (float*)((base) + ML_SEMT); float* sWC = (float*)((base) + ML_SWC); \
  float* sNQ = (float*)((base) + ML_SNQ); float* sRD = (float*)((base) + ML_SRD); float* sN = (float*)((base) + ML_SN);  \
  float* misc = (float*)((base) + ML_MISC); float* CW = (float*)((base) + ML_CW); float* GN = (float*)((base) + ML_GN);  \
  (void)Qs; (void)Ks; (void)K2s; (void)Vs; (void)Cb; (void)AQ; (void)Hs; (void)RAW; (void)sG; (void)sM; (void)sSC;       \
  (void)sEMT; (void)sWC; (void)sNQ; (void)sRD; (void)sN; (void)misc; (void)CW; (void)GN;

struct MlRegs { uint4 raw[5]; };

__device__ __forceinline__ void ml_issue(const P& p, int tid, int l, int type, int b, int h, int tb, int L, MlRegs& rg) {
  const bf16* Z = (const bf16*)(p.ws + OFF_BIG);
#pragma unroll
  for (int i = 0; i < 5; ++i) {
    rg.raw[i] = make_uint4(0, 0, 0, 0);
    const int idx = tid + NTHR * i;
    const int rr = idx >> 5, vq = idx & 31;
    if (rr < L + 3) {
      const int t = tb - 3 + rr;
      const int qc = (vq >> 4) * 512 + h * 128 + (vq & 15) * 8;
      if (t >= 0) rg.raw[i] = *(const uint4*)(Z + (size_t)seq_row(type, b, t) * ZW + 1792 + qc);
      else if (type) {
        const float* cs = p.in[7] + (((size_t)l * 128 + b) * 3 + (t + 3)) * 1024 + qc;
        float f[8];
#pragma unroll
        for (int e = 0; e < 8; ++e) f[e] = cs[e];
        rg.raw[i] = pack8(f);
      }
    }
  }
}

__device__ __forceinline__ void mlstm_item(const P& p, int l, int type, int b, int h, unsigned char* lds) {
  const int tid = tidx(), lane = tid & 63, wave = tid >> 6;
  const int r31 = lane & 31, hh = lane >> 5;
  const bf16* Z = (const bf16*)(p.ws + OFF_BIG);
  const float* G = (const float*)(p.ws + OFF_G);
  const int nchunks = type ? 1 : 33;
  const float ibias = p.in[23][l * 4 + h], fbias = p.in[24][l * 4 + h];

  const int kt = wave >> 1, vt0 = (wave & 1) * 2;
  f32x16 cacc[2];
  MlRegs rg;
  ml_issue(p, tid, l, type, b, h, 0, type ? 8 : 16, rg);
  {
  ML_PTRS(lds)
  if (type) {
    const float* c0 = p.in[4] + (((size_t)l * 128 + b) * 4 + h) * 16384;
#pragma unroll
    for (int x = 0; x < 2; ++x) {
      int v = (vt0 + x) * 32 + r31;
#pragma unroll
      for (int g = 0; g < 4; ++g) {
        float4 q = *(const float4*)(c0 + (size_t)v * 128 + kt * 32 + 8 * g + 4 * hh);
        cacc[x][4 * g] = q.x; cacc[x][4 * g + 1] = q.y; cacc[x][4 * g + 2] = q.z; cacc[x][4 * g + 3] = q.w;
      }
    }
    if (tid < 128) sN[tid] = p.in[5][(((size_t)l * 128 + b) * 4 + h) * 128 + tid];
    if (tid == 0) misc[0] = p.in[6][((size_t)l * 128 + b) * 4 + h];
  } else {
#pragma unroll
    for (int x = 0; x < 2; ++x)
#pragma unroll
      for (int i = 0; i < 16; ++i) cacc[x][i] = 0.f;
    if (tid < 128) sN[tid] = 0.f;
    if (tid == 0) misc[0] = 0.f;
  }
  for (int e = tid; e < 1280; e += NTHR) {
    const int kind = e / 640, r = e % 640, i = r >> 7, c = r & 127;
    const int qc = kind * 512 + h * 128 + c;
    CW[e] = i < 4 ? p.in[21][((size_t)l * 4 + i) * 1024 + qc] : p.in[22][l * 1024 + qc];
  }
  if (tid < 128) GN[tid] = p.in[25][l * 512 + h * 128 + tid];
#pragma unroll
  for (int x = 0; x < 2; ++x) {
    int v = (vt0 + x) * 32 + r31;
#pragma unroll
    for (int g = 0; g < 4; ++g) {
      uint2 pk; pk.x = pack2(cacc[x][4 * g], cacc[x][4 * g + 1]); pk.y = pack2(cacc[x][4 * g + 2], cacc[x][4 * g + 3]);
      *(uint2*)(Cb + v * 136 + kt * 32 + 8 * g + 4 * hh) = pk;
    }
  }
  }
  float g_ig = 0.f, g_fg = 0.f;
  if (wave == 0 && lane < (type ? 8 : 16)) {
    int row = seq_row(type, b, lane);
    g_ig = G[(size_t)row * 8 + h]; g_fg = G[(size_t)row * 8 + 4 + h];
  }
  __syncthreads();

#pragma unroll 1
  for (int c = 0; c < nchunks; ++c) {
    int opq = 0;
    asm volatile("" : "+v"(opq));
    unsigned char* ldsv = lds + opq;
    ML_PTRS(ldsv)
    const int L = type ? 8 : (c == 0 ? 16 : 64);
    const int tb = type ? 0 : (c == 0 ? 0 : 16 + (c - 1) * 64);
    const float m_prev = misc[0];
    if (wave == 0) {
      float lf = 0.f, ig = 0.f;
      if (lane < L) { ig = g_ig + ibias; lf = -softplusf(-(g_fg + fbias)); }
      float bt = lf;
#pragma unroll
      for (int o = 1; o < 64; o <<= 1) { float t = __shfl_up(bt, o); if (lane >= o) bt += t; }
      float g = lane < L ? ig - bt : -INFINITY;
      float pm = g;
#pragma unroll
      for (int o = 1; o < 64; o <<= 1) { float t = __shfl_up(pm, o); if (lane >= o) pm = fmaxf(pm, t); }
      float M = fmaxf(m_prev, pm);
      float ML = __shfl(M, L - 1), btL = __shfl(bt, L - 1);
      sG[lane] = g; sM[lane] = M; sSC[lane] = __expf(m_prev - M); sEMT[lane] = __expf(-(bt + M));
      sWC[lane] = lane < L ? __expf(g - ML) : 0.f;
      if (lane == 0) { misc[1] = __expf(m_prev - ML); misc[2] = btL + ML; }
      if (c + 1 < nchunks) {
        g_ig = 0.f; g_fg = 0.f;
        int row = seq_row(type, b, tb + L + lane);
        g_ig = G[(size_t)row * 8 + h]; g_fg = G[(size_t)row * 8 + 4 + h];
      }
    }
#pragma unroll
    for (int i = 0; i < 5; ++i) {
      const int idx = tid + NTHR * i;
      const int rr = idx >> 5, vq = idx & 31;
      if (rr < 67) *(uint4*)(RAW + rr * 264 + vq * 8) = rg.raw[i];
    }
#pragma unroll
    for (int i = 0; i < 2; ++i) {
      const int idx = tid + NTHR * i;
      const int j = idx >> 4, c0 = (idx & 15) * 8;
      uint4 vv4 = make_uint4(0, 0, 0, 0);
      if (j < L) vv4 = *(const uint4*)(Z + (size_t)seq_row(type, b, tb + j) * ZW + 1792 + 1024 + h * 128 + c0);
      *(uint4*)(Vs + j * 136 + c0) = vv4;
    }
    __syncthreads();
#pragma unroll 1
    for (int it = 0; it < 4; ++it) {
      const int kind = it >> 1;
      const int idx = tid + NTHR * (it & 1);
      const int j = idx >> 4, c0 = (idx & 15) * 8;
      float val[8];
#pragma unroll
      for (int e = 0; e < 8; ++e) val[e] = 0.f;
      if (j < L) {
        const float* cwk = CW + kind * 640 + c0;
        float4 b0 = *(const float4*)(cwk + 512), b1 = *(const float4*)(cwk + 516);
        val[0] = b0.x; val[1] = b0.y; val[2] = b0.z; val[3] = b0.w; val[4] = b1.x; val[5] = b1.y; val[6] = b1.z; val[7] = b1.w;
#pragma unroll
        for (int i = 0; i < 4; ++i) {
          uint4 raw = *(const uint4*)(RAW + (j + i) * 264 + kind * 128 + c0);
          float rv[8]; unpack8(raw, rv);
          float4 w0 = *(const float4*)(cwk + i * 128), w1 = *(const float4*)(cwk + i * 128 + 4);
          val[0] += rv[0] * w0.x; val[1] += rv[1] * w0.y; val[2] += rv[2] * w0.z; val[3] += rv[3] * w0.w;
          val[4] += rv[4] * w1.x; val[5] += rv[5] * w1.y; val[6] += rv[6] * w1.z; val[7] += rv[7] * w1.w;
        }
        const float sc = kind == 1 ? 0.08838834764831845f : 1.f;
#pragma unroll
        for (int e = 0; e < 8; ++e) val[e] = val[e] * sigmoidf(val[e]) * sc;
      }
      if (kind == 0) *(uint4*)(Qs + j * 136 + c0) = pack8(val);
      else {
        *(uint4*)(Ks + j * 136 + c0) = pack8(val);
        float wc = sWC[j];
#pragma unroll
        for (int e = 0; e < 8; ++e) val[e] *= wc;
        *(uint4*)(K2s + j * 136 + c0) = pack8(val);
      }
    }
    __syncthreads();
    if (wave < 4) {
      const int tl = wave >> 1, ts = wave & 1;
      f32x16 acc = {0};
      if (!(tl == 0 && ts == 1)) {
#pragma unroll 2
        for (int ks = 0; ks < 8; ++ks) {
          b8 a = *(const b8*)(Qs + (tl * 32 + r31) * 136 + ks * 16 + hh * 8);
          b8 bb = *(const b8*)(Ks + (ts * 32 + r31) * 136 + ks * 16 + hh * 8);
          acc = __builtin_amdgcn_mfma_f32_32x32x16_bf16(a, bb, acc, 0, 0, 0);
        }
      }
      const int s = ts * 32 + r31;
      const float gs = sG[s];
#pragma unroll
      for (int i = 0; i < 16; ++i) {
        int lr = tl * 32 + (i & 3) + 8 * (i >> 2) + 4 * hh;
        float a = (s <= lr && s < L) ? __expf(gs - sM[lr]) * acc[i] : 0.f;
        AQ[lr * 72 + s] = f2bf(a);
      }
    } else {
      const int t2 = tid - 256, lr = t2 >> 2, part = t2 & 3;
      float s = 0.f;
#pragma unroll
      for (int e8 = 0; e8 < 4; ++e8) {
        uint4 raw = *(const uint4*)(Qs + lr * 136 + part * 32 + e8 * 8);
        float f[8]; unpack8(raw, f);
        float4 n0 = *(const float4*)(sN + part * 32 + e8 * 8), n1 = *(const float4*)(sN + part * 32 + e8 * 8 + 4);
        s += f[0] * n0.x + f[1] * n0.y + f[2] * n0.z + f[3] * n0.w + f[4] * n1.x + f[5] * n1.y + f[6] * n1.z + f[7] * n1.w;
      }
      s += __shfl_xor(s, 1); s += __shfl_xor(s, 2);
      if (part == 0) sNQ[lr] = s;
    }
    __syncthreads();
    {
      const int lr = tid >> 3, part = tid & 7;
      uint4 raw = *(const uint4*)(AQ + lr * 72 + part * 8);
      float f[8]; unpack8(raw, f);
      float s = f[0] + f[1] + f[2] + f[3] + f[4] + f[5] + f[6] + f[7];
      s += __shfl_xor(s, 1); s += __shfl_xor(s, 2); s += __shfl_xor(s, 4);
      if (part == 0) {
        float den = s + sSC[lr] * sNQ[lr];
        sRD[lr] = 1.f / fmaxf(fabsf(den), sEMT[lr]);
      }
    }
    __syncthreads();
    if (c + 1 < nchunks) ml_issue(p, tid, l, type, b, h, tb + L, 64, rg);
    uint4 o0 = make_uint4(0, 0, 0, 0), o1 = make_uint4(0, 0, 0, 0);
    {
      const int lr = tid >> 3, part = tid & 7;
      if (lr < L) {
        const bf16* zo = Z + (size_t)seq_row(type, b, tb + lr) * ZW + 1792 + 1536 + h * 128 + part * 16;
        o0 = *(const uint4*)zo; o1 = *(const uint4*)(zo + 8);
      }
    }
    {
      const int li = wave >> 2, vi = wave & 3;
      f32x16 acc = {0};
#pragma unroll 2
      for (int ks = 0; ks < 8; ++ks) {
        b8 a = *(const b8*)(Qs + (li * 32 + r31) * 136 + ks * 16 + hh * 8);
        b8 bb = *(const b8*)(Cb + (vi * 32 + r31) * 136 + ks * 16 + hh * 8);
        acc = __builtin_amdgcn_mfma_f32_32x32x16_bf16(a, bb, acc, 0, 0, 0);
      }
#pragma unroll
      for (int i = 0; i < 16; ++i) acc[i] *= sSC[li * 32 + (i & 3) + 8 * (i >> 2) + 4 * hh];
#pragma unroll 1
      for (int ks = 0; ks < 4; ++ks) {
        b8 a = *(const b8*)(AQ + (li * 32 + r31) * 72 + ks * 16 + hh * 8);
        b8 bb = gather_frag(Vs + (ks * 16 + hh * 8) * 136 + vi * 32 + r31);
        acc = __builtin_amdgcn_mfma_f32_32x32x16_bf16(a, bb, acc, 0, 0, 0);
      }
#pragma unroll
      for (int i = 0; i < 16; ++i) {
        int lr = li * 32 + (i & 3) + 8 * (i >> 2) + 4 * hh;
        Hs[lr * 132 + vi * 32 + r31] = acc[i] * sRD[lr];
      }
      if (tid < 128) {
        float s0 = 0.f, s1 = 0.f, s2 = 0.f, s3 = 0.f;
#pragma unroll 4
        for (int j = 0; j < 64; j += 4) {
          s0 += bf2f(K2s[j * 136 + tid]); s1 += bf2f(K2s[(j + 1) * 136 + tid]);
          s2 += bf2f(K2s[(j + 2) * 136 + tid]); s3 += bf2f(K2s[(j + 3) * 136 + tid]);
        }
        sN[tid] = misc[1] * sN[tid] + ((s0 + s1) + (s2 + s3));
      }
    }
    __syncthreads();
    {
      const int lr = tid >> 3, part = tid & 7;
      float x[16];
#pragma unroll
      for (int q = 0; q < 4; ++q) {
        float4 v = *(const float4*)(Hs + lr * 132 + part * 16 + q * 4);
        x[4 * q] = v.x; x[4 * q + 1] = v.y; x[4 * q + 2] = v.z; x[4 * q + 3] = v.w;
      }
      float s = 0.f;
#pragma unroll
      for (int e = 0; e < 16; ++e) s += x[e];
      s += __shfl_xor(s, 1); s += __shfl_xor(s, 2); s += __shfl_xor(s, 4);
      float mean = s * (1.f / 128.f);
      float vs = 0.f;
#pragma unroll
      for (int e = 0; e < 16; ++e) { x[e] -= mean; vs += x[e] * x[e]; }
      vs += __shfl_xor(vs, 1); vs += __shfl_xor(vs, 2); vs += __shfl_xor(vs, 4);
      float rs = rsqrtf(vs * (1.f / 128.f) + 1e-5f);
      if (lr < L) {
        int row = seq_row(type, b, tb + lr);
        bf16* yb = (bf16*)(p.ws + OFF_YB) + (size_t)row * 512 + h * 128 + part * 16;
        {
          float of[8], y[8]; unpack8(o0, of);
#pragma unroll
          for (int e = 0; e < 8; ++e) y[e] = x[e] * rs * GN[part * 16 + e] * sigmoidf(of[e]);
          *(uint4*)yb = pack8(y);
        }
        {
          float of[8], y[8]; unpack8(o1, of);
#pragma unroll
          for (int e = 0; e < 8; ++e) y[e] = x[8 + e] * rs * GN[part * 16 + 8 + e] * sigmoidf(of[e]);
          *(uint4*)(yb + 8) = pack8(y);
        }
      }
      __builtin_amdgcn_sched_barrier(0);
      const float dec = misc[1];
#pragma unroll
      for (int x2 = 0; x2 < 2; ++x2)
#pragma unroll
        for (int i = 0; i < 16; ++i) cacc[x2][i] *= dec;
#pragma unroll 1
      for (int ks = 0; ks < 4; ++ks) {
        b8 a = gather_frag(K2s + (ks * 16 + hh * 8) * 136 + kt * 32 + r31);
#pragma unroll
        for (int x2 = 0; x2 < 2; ++x2) {
          b8 bb = gather_frag(Vs + (ks * 16 + hh * 8) * 136 + (vt0 + x2) * 32 + r31);
          cacc[x2] = __builtin_amdgcn_mfma_f32_32x32x16_bf16(a, bb, cacc[x2], 0, 0, 0);
        }
      }
#pragma unroll
      for (int x2 = 0; x2 < 2; ++x2) {
        int v = (vt0 + x2) * 32 + r31;
#pragma unroll
        for (int g = 0; g < 4; ++g) {
          uint2 pk; pk.x = pack2(cacc[x2][4 * g], cacc[x2][4 * g + 1]); pk.y = pack2(cacc[x2][4 * g + 2], cacc[x2][4 * g + 3]);
          *(uint2*)(Cb + v * 136 + kt * 32 + 8 * g + 4 * hh) = pk;
        }
      }
      if (tid == 0) misc[0] = misc[2];
    }
    __syncthreads();
  }
  {
    ML_PTRS(lds)
    const size_t sidx = type ? ((size_t)l * 128 + b) * 4 + h : ((size_t)l * 8 + b) * 4 + h;
    float* co = p.out + (type ? O_SC : O_PC) + sidx * 16384;
#pragma unroll
    for (int x = 0; x < 2; ++x) {
      int v = (vt0 + x) * 32 + r31;
#pragma unroll
      for (int g = 0; g < 4; ++g)
        *(float4*)(co + (size_t)v * 128 + kt * 32 + 8 * g + 4 * hh) =
            make_float4(cacc[x][4 * g], cacc[x][4 * g + 1], cacc[x][4 * g + 2], cacc[x][4 * g + 3]);
    }
    if (tid < 128) p.out[(type ? O_SN : O_PN) + sidx * 128 + tid] = sN[tid];
    if (tid == 0) p.out[(type ? O_SM : O_PM) + sidx] = misc[0];
  }
  __syncthreads();
}

__device__ __forceinline__ void phase_mixers(const P& p, int l, unsigned char* lds) {
  const int nb = gridDim.x, bid = blockIdx.x;
  {
    const bf16* Z = (const bf16*)(p.ws + OFF_BIG);
    const int total = 136 * 4864;
    const int tid = tidx();
    for (int i = bid * NTHR + tid; i < total; i += nb * NTHR) {
      int sq = i / 4864, e = i % 4864;
      int type = sq >= 8, b = type ? sq - 8 : sq;
      int T = type ? 8 : 2064;
      if (e < 1792) {
        float v = bf2f(Z[(size_t)seq_row(type, b, T - 1) * ZW + e]);
        if (type) p.out[O_SSH + ((size_t)l * 128 + b) * 1792 + e] = v; else p.out[O_PSH + ((size_t)l * 8 + b) * 1792 + e] = v;
      } else {
        int e2 = e - 1792, j = e2 >> 10, cc = e2 & 1023;
        float v = bf2f(Z[(size_t)seq_row(type, b, T - 3 + j) * ZW + 1792 + cc]);
        if (type) p.out[O_SCV + (((size_t)l * 128 + b) * 3 + j) * 1024 + cc] = v; else p.out[O_PCV + (((size_t)l * 8 + b) * 3 + j) * 1024 + cc] = v;
      }
    }
  }
  const int BIGN = 1 << 24;
  int r0 = BIGN, rs = BIGN, m0 = BIGN, ms = BIGN, role = 0;
  if (nb >= 224) {
    if (bid < 64) role = 1;
    else if (bid < 96) { m0 = bid - 64; }
    else if (bid < 160) role = 2;
    else { r0 = 64 + (bid - 160); rs = nb - 160; m0 = 32 + (bid - 160); ms = nb - 160; }
  } else { r0 = bid; rs = nb; m0 = bid; ms = nb; }
#ifndef NO_CONS
  if (role == 1) rwkv_consumer(p, l, bid >> 3, bid & 7, lds);
#endif
#ifndef NO_PROD
  if (role == 2) rwkv_producer(p, l, (bid - 96) >> 3, (bid - 96) & 7, lds);
#endif
  if (role == 0) {
#pragma unroll 1
    for (int it = r0; it < 64 + 1024; it += rs) { int type = it >= 64, x = type ? it - 64 : it; rwkv_item(p, l, type, x >> 3, x & 7, lds); }
#pragma unroll 1
    for (int it = m0; it < 32 + 512; it += ms) { int type = it >= 32, x = type ? it - 32 : it; mlstm_item(p, l, type, x >> 2, x & 3, lds); }
  }
}

#define XB_TMO      128
#define XB_XCNT(j)  (256  + 64 * (j))
#define XB_XSUB(j)  (1280 + 64 * (j))
#define XB_XGEN(j)  (2304 + 64 * (j))
#define XB_TOP      3328
#define XB_TOPGEN   3392
#define XCD_BAR_WORDS 3456
#define XB_SPIN_CAP (1u << 20)
__device__ __forceinline__ unsigned xb_ld(unsigned* p)              { return __hip_atomic_load(p, __ATOMIC_RELAXED, __HIP_MEMORY_SCOPE_AGENT); }
__device__ __forceinline__ unsigned xb_add(unsigned* p, unsigned v) { return __hip_atomic_fetch_add(p, v, __ATOMIC_RELAXED, __HIP_MEMORY_SCOPE_AGENT); }
__device__ __forceinline__ unsigned xb_xcc_id() { return (unsigned)__builtin_amdgcn_s_getreg((3 << 11) | 20) & 0xFu; }
#define XB_SPIN(cond, bar) do { unsigned _sp = 0; while (cond) { __builtin_amdgcn_s_sleep(1); \
    if ((++_sp & 255u) == 0u) { if (xb_ld(&(bar)[XB_TMO])) break; if (_sp > XB_SPIN_CAP) { atomicAdd(&(bar)[XB_TMO], 1u); break; } } } } while (0)
struct XcdBarrier { unsigned* bar; unsigned x; volatile PG8_LAS unsigned* st; };
__device__ __forceinline__ XcdBarrier xcd_barrier_post(unsigned* bar, volatile PG8_LAS unsigned* st) {
  XcdBarrier b; b.bar = bar; b.x = xb_xcc_id(); b.st = st;
  if (threadIdx.x == 0) (void)xb_add(&bar[XB_XCNT(b.x)], 1u);
  return b;
}
__device__ __forceinline__ void xcd_barrier_complete(unsigned* bar, unsigned x, unsigned& nloc, unsigned& nx) {
  const unsigned G = gridDim.x * gridDim.y * gridDim.z;
  unsigned sum, cnt, mine, sp = 0u;
  for (;;) {
    sum = 0u; cnt = 0u; mine = 0u;
#pragma unroll
    for (unsigned j = 0; j < 16; ++j) { const unsigned c = xb_ld(&bar[XB_XCNT(j)]); sum += c; cnt += (c > 0u) ? 1u : 0u; mine = (j == x) ? c : mine; }
    if (sum == G) break;
    __builtin_amdgcn_s_sleep(1);
    if ((++sp & 255u) == 0u) { if (xb_ld(&bar[XB_TMO])) break; if (sp > XB_SPIN_CAP) { atomicAdd(&bar[XB_TMO], 1u); break; } }
  }
  nloc = mine > 0u ? mine : 1u; nx = cnt > 0u ? cnt : 1u;
}
__device__ __forceinline__ void xcd_barrier(const XcdBarrier& b) {
  asm volatile("s_waitcnt vmcnt(0)" ::: "memory");
  __syncthreads();
  if (threadIdx.x == 0) {
    unsigned* bar = b.bar;
    __builtin_amdgcn_s_waitcnt(0);
    unsigned nloc = b.st[0], nx = b.st[1];
    if (nloc == 0u) { xcd_barrier_complete(bar, b.x, nloc, nx); b.st[0] = nloc; b.st[1] = nx; }
    const unsigned old = xb_add(&bar[XB_XSUB(b.x)], 1u);
    const unsigned gen = old / nloc;
    if (old + 1u == (gen + 1u) * nloc) {
      __builtin_amdgcn_fence(__ATOMIC_RELEASE, "agent");
      asm volatile("s_waitcnt vmcnt(0)" ::: "memory");
      const unsigned og = xb_add(&bar[XB_TOP], 1u);
      const unsigned tg = og / nx;
      if (og + 1u == (tg + 1u) * nx) xb_add(&bar[XB_TOPGEN], 1u);
      else XB_SPIN(xb_ld(&bar[XB_TOPGEN]) == tg, bar);
      __builtin_amdgcn_fence(__ATOMIC_ACQUIRE, "agent");
      xb_add(&bar[XB_XGEN(b.x)], 1u);
      asm volatile("s_waitcnt vmcnt(0)" ::: "memory");
    } else {
      XB_SPIN(xb_ld(&bar[XB_XGEN(b.x)]) == gen, bar);
      __builtin_amdgcn_fence(__ATOMIC_ACQUIRE, "agent");
      asm volatile("s_waitcnt vmcnt(0)" ::: "memory");
    }
  }
  __syncthreads();
}

__global__ void __launch_bounds__(NTHR) __attribute__((target("no-packed-fp32-ops"))) mega(P p) {
  extern __shared__ __attribute__((aligned(16))) unsigned char lds[];
  cg::grid_group grid = cg::this_grid();
  volatile PG8_LAS unsigned* xst = (volatile PG8_LAS unsigned*)(LDS3(lds) + (LDS_BYTES - 16));
  if (threadIdx.x == 0) { xst[0] = 0u; xst[1] = 0u; }
  __syncthreads();
  const XcdBarrier xb = xcd_barrier_post((unsigned*)(p.ws + OFF_BAR), xst);
#ifndef ONLY
#define ONLY 0xFFFF
#endif
  if (blockIdx.x == 0) { unsigned* fl = (unsigned*)(p.ws + OFF_FLAG); for (int i = threadIdx.x; i < 2 * 64 * 64; i += NTHR) fl[i] = 0u; }
  if (ONLY & 1) phase_convert(p, lds);
  if (ONLY & 2) phase_init_rows(p);
  if (p.ws == nullptr) grid.sync();
  xcd_barrier(xb);
#pragma unroll 1
  for (int l = 0; l < 2; ++l) {
    if (ONLY & 4) phase_gemm_in(p, l, lds);
    xcd_barrier(xb);
#ifndef MIXREP
#define MIXREP 1
#endif
#pragma unroll 1
    for (int rep = 0; rep < MIXREP; ++rep) {
#ifndef REPMODE
#define REPMODE 3
#endif
      if (ONLY & 8) phase_mixers(p, l, lds);
      xcd_barrier(xb);
    }
    if (ONLY & 16) phase_gemm_v(p, l, lds);
    if (ONLY & 16) phase_gemm_gate(p, l, lds);
    if (ONLY & 32) phase_gemm_out(p, l, lds);
    xcd_barrier(xb);
    if (ONLY & 64) phase_post1(p, l);
    xcd_barrier(xb);
#pragma unroll 1
    for (int hf = 0; hf < 2; ++hf) {
      if (ONLY & 128) phase_gemm_up(p, l, hf, lds);
      if (ONLY & 256) phase_gemm_down(p, l, hf, lds);
      xcd_barrier(xb);
    }
    if (ONLY & 512) phase_post2(p, l);
    if (l == 0) xcd_barrier(xb);
  }
}

extern "C" void kernel_launch(void* const* d_in, const int* in_sizes, int n_in, void* d_out, int out_size,
                              void* d_ws, size_t ws_size, hipStream_t stream) {
  static int grid_blocks = 0;
  if (!grid_blocks) {
    if (n_in != 35 || (size_t)out_size != O_END || ws_size < WS_END) {
      fprintf(stderr, "kernel_launch: unexpected sizes n_in=%d out=%d ws=%zu (need %zu)\n", n_in, out_size, ws_size, (size_t)WS_END);
      grid_blocks = -1; return;
    }
    int dev = 0, cus = 0, per_cu = 0;
    (void)hipGetDevice(&dev);
    (void)hipDeviceGetAttribute(&cus, hipDeviceAttributeMultiprocessorCount, dev);
    (void)hipFuncSetAttribute((const void*)mega, hipFuncAttributeMaxDynamicSharedMemorySize, LDS_BYTES);
    (void)hipOccupancyMaxActiveBlocksPerMultiprocessor(&per_cu, (const void*)mega, NTHR, LDS_BYTES);
    if (per_cu < 1) per_cu = 1;
    grid_blocks = cus * per_cu;
  }
  if (grid_blocks < 0) return;
  P p{};
  for (int i = 0; i < 35; ++i) p.in[i] = (const float*)d_in[i];
  p.out = (float*)d_out; p.ws = (unsigned char*)d_ws;
  (void)hipMemsetAsync((unsigned char*)d_ws + OFF_BAR, 0, 16384 + 110592, stream);
  void* args[] = {&p};
  hipError_t e = hipLaunchCooperativeKernel((void*)mega, dim3(grid_blocks), dim3(NTHR), args, LDS_BYTES, stream);
  if (e != hipSuccess) fprintf(stderr, "cooperative launch failed: %s (grid %d)\n", hipGetErrorString(e), grid_blocks);
}
```
